# Optimizing an MI355X kernel written in HIP

```python
import jax, jax.numpy as jnp
from jax import lax
import numpy as np

D_MODEL = 1024
BATCH = 16
SEQ = 256
DEPTH = 4
DEC_BATCH = 4
DEC_SEQ = 4096
PAST_LEN = 512

GRID_W = 64
N_MIXERS = 3
N_A = (DEPTH + 2) // 3
N_B = (DEPTH + 1) // 3
N_C = DEPTH // 3
N_MOD = 9
D_FF = 2816
CHUNK = 128
D_A = 2 * D_MODEL
G_A = 8
C_A = D_A // G_A
HQ_B = 8
KV_B = 2
HD_B = D_MODEL // HQ_B
HQ_C = 16
KV_C = 2
HD_C = D_MODEL // HQ_C
WINDOW = 128
QBLK = 128
ROPE_THETA = 10000.0
EPS = 1e-6
NEG_INF = -1e30

kernel_name = 'hybrid_flow_prefix_trunk_step'


def rmsnorm(x, g):
    xf = x.astype(jnp.float32)
    y = xf * lax.rsqrt(jnp.mean(xf * xf, axis=-1, keepdims=True) + EPS)
    return (y * g.astype(jnp.float32)).astype(x.dtype)


def modulate(h, shift, scale):
    return h * (1 + scale[:, None, :]) + shift[:, None, :]


def ada_params(cond, w_mod, b_mod):
    m = jax.nn.silu(cond) @ w_mod + b_mod
    return m.reshape(cond.shape[0], N_MOD, D_MODEL)


def swiglu(h, w_gate, w_up, w_down):
    return (jax.nn.silu(h @ w_gate) * (h @ w_up)) @ w_down


def ffn_half_step(x, mod, k, g, w_gate, w_up, w_down):
    h = modulate(rmsnorm(x, g), mod[:, k], mod[:, k + 1])
    return x + 0.5 * mod[:, k + 2][:, None, :] * swiglu(h, w_gate, w_up, w_down)


def chunk_gating_mlp(h, w_in, norm_g, w_s, b_s, w_out):
    n, t, _ = h.shape
    u, v = jnp.split(h @ w_in, 2, axis=-1)
    v = rmsnorm(v, norm_g).reshape(n, t // CHUNK, CHUNK, G_A, C_A)
    v = jnp.einsum('gpq,bnqgc->bnpgc', w_s, v) + b_s.T[None, None, :, :, None]
    return (u * v.reshape(n, t, D_A)) @ w_out


def axial_rope_tables(n, hd):
    rows = n // GRID_W
    row = jnp.repeat(jnp.arange(rows), GRID_W).astype(jnp.float32)
    col = (jnp.arange(n) % GRID_W).astype(jnp.float32)
    quarter = hd // 4
    inv = ROPE_THETA ** (-jnp.arange(quarter, dtype=jnp.float32) / quarter)
    ang_r = row[:, None] * inv[None, :]
    ang_c = col[:, None] * inv[None, :]
    return jnp.cos(ang_r), jnp.sin(ang_r), jnp.cos(ang_c), jnp.sin(ang_c)


def _rotate(z, cos, sin):
    z1, z2 = jnp.split(z, 2, axis=-1)
    cos = cos[None, :, None, :]
    sin = sin[None, :, None, :]
    return jnp.concatenate([z1 * cos - z2 * sin, z2 * cos + z1 * sin], axis=-1)


def axial_rope(x, cos_r, sin_r, cos_c, sin_c):
    xf = x.astype(jnp.float32)
    half = x.shape[-1] // 2
    out = jnp.concatenate([_rotate(xf[..., :half], cos_r, sin_r), _rotate(xf[..., half:], cos_c, sin_c)], axis=-1)
    return out.astype(x.dtype)


def gqa_softmax(q, k, v, mask, sink):
    kv, g, hd = q.shape[2], q.shape[3], q.shape[4]
    s = jnp.einsum('bqkgd,bskd->bkgqs', q, k).astype(jnp.float32) * (hd ** -0.5)
    if mask is not None:
        s = jnp.where(mask, s, NEG_INF)
    if sink is None:
        p = jax.nn.softmax(s, axis=-1)
    else:
        sk = sink.astype(jnp.float32).reshape(kv, g)[None, :, :, None, None]
        m = jnp.maximum(jnp.max(s, axis=-1, keepdims=True), sk)
        e = jnp.exp(s - m)
        p = e / (jnp.sum(e, axis=-1, keepdims=True) + jnp.exp(sk - m))
    return jnp.einsum('bkgqs,bskd->bqkgd', p.astype(v.dtype), v)


def dense_blocked_attention(q, k, v, sink):
    n, t, hq, hd = q.shape
    kv = k.shape[2]
    nb = t // QBLK
    qb = q.reshape(n, nb, QBLK, kv, hq // kv, hd).swapaxes(0, 1)
    out = lax.map(lambda qi: gqa_softmax(qi, k, v, None, sink), qb)
    return out.swapaxes(0, 1).reshape(n, t, hq * hd)


def banded_attention(q, k, v, ck, cv, sink):
    n, t, hq, hd = q.shape
    kv = k.shape[2]
    g = hq // kv
    nb = t // QBLK
    sc = ck.shape[1]
    band = QBLK + 2 * WINDOW
    pad = ((0, 0), (WINDOW, WINDOW), (0, 0), (0, 0))
    kpad = jnp.pad(k, pad)
    vpad = jnp.pad(v, pad)
    ctx_mask = jnp.ones((QBLK, sc), dtype=bool)

    def block(j):
        start = j * QBLK
        qi = lax.dynamic_slice_in_dim(q, start, QBLK, axis=1).reshape(n, QBLK, kv, g, hd)
        kb = lax.dynamic_slice_in_dim(kpad, start, band, axis=1)
        vb = lax.dynamic_slice_in_dim(vpad, start, band, axis=1)
        qpos = start + jnp.arange(QBLK)
        kpos = start - WINDOW + jnp.arange(band)
        near = (jnp.abs(qpos[:, None] - kpos[None, :]) <= WINDOW) & (kpos[None, :] >= 0) & (kpos[None, :] < t)
        mask = jnp.concatenate([ctx_mask, near], axis=1)
        return gqa_softmax(qi, jnp.concatenate([ck, kb], axis=1), jnp.concatenate([cv, vb], axis=1), mask, sink)

    out = lax.map(block, jnp.arange(nb))
    return out.swapaxes(0, 1).reshape(n, t, hq * hd)


def split_qkv(h, w_qkv, hq, kv, hd):
    n, t, _ = h.shape
    q, k, v = jnp.split(h @ w_qkv, [hq * hd, (hq + kv) * hd], axis=-1)
    return q.reshape(n, t, hq, hd), k.reshape(n, t, kv, hd), v.reshape(n, t, kv, hd)


def full_attn_context(h, w_qkv, q_g, k_g, w_out):
    q, k, v = split_qkv(h, w_qkv, HQ_B, KV_B, HD_B)
    q = rmsnorm(q, q_g)
    k = rmsnorm(k, k_g)
    return dense_blocked_attention(q, k, v, None) @ w_out, k, v


def full_attn_latent(h, ck, cv, w_qkv, q_g, k_g, w_out):
    q, k, v = split_qkv(h, w_qkv, HQ_B, KV_B, HD_B)
    tables = axial_rope_tables(h.shape[1], HD_B)
    q = axial_rope(rmsnorm(q, q_g), *tables)
    k = axial_rope(rmsnorm(k, k_g), *tables)
    o = dense_blocked_attention(q, jnp.concatenate([ck, k], axis=1), jnp.concatenate([cv, v], axis=1), None)
    return o @ w_out


def window_attn_context(h, w_qkv, sink, w_out):
    q, k, v = split_qkv(h, w_qkv, HQ_C, KV_C, HD_C)
    return dense_blocked_attention(q, k, v, sink) @ w_out, k, v


def window_attn_latent(h, ck, cv, w_qkv, sink, w_out):
    q, k, v = split_qkv(h, w_qkv, HQ_C, KV_C, HD_C)
    tables = axial_rope_tables(h.shape[1], HD_C)
    q = axial_rope(q, *tables)
    k = axial_rope(k, *tables)
    return banded_attention(q, k, v, ck, cv, sink) @ w_out


def setup_inputs(seed: int = 0) -> dict:
    key = jax.random.key(seed)
    ks = jax.random.split(key, 32)

    def nrm(k, shape, scale=1.0):
        return scale * jax.random.normal(k, shape, jnp.float32)

    qkv_b = (HQ_B + 2 * KV_B) * HD_B
    qkv_c = (HQ_C + 2 * KV_C) * HD_C
    return {
        'x_prompt': nrm(ks[0], (BATCH, SEQ, D_MODEL)),
        'x_sample': nrm(ks[1], (DEC_BATCH, DEC_SEQ, D_MODEL)),
        'cache_b_k': nrm(ks[2], (DEC_BATCH, N_B, PAST_LEN, KV_B, HD_B)),
        'cache_b_v': nrm(ks[3], (DEC_BATCH, N_B, PAST_LEN, KV_B, HD_B)),
        'cache_c_k': nrm(ks[4], (DEC_BATCH, N_C, PAST_LEN, KV_C, HD_C)),
        'cache_c_v': nrm(ks[5], (DEC_BATCH, N_C, PAST_LEN, KV_C, HD_C)),
        'c': nrm(ks[6], (DEC_BATCH, D_MODEL)),
        'c_ctx': nrm(ks[7], (D_MODEL,)),
        'w_mod': nrm(ks[8], (DEPTH, D_MODEL, N_MOD * D_MODEL), 0.5 * D_MODEL ** -0.5),
        'b_mod': nrm(ks[9], (DEPTH, N_MOD * D_MODEL), 0.01),
        'norm_g': 1.0 + nrm(ks[10], (DEPTH, 3, D_MODEL), 0.02),
        'ffn_w_gate': nrm(ks[11], (DEPTH, 2, D_MODEL, D_FF), D_MODEL ** -0.5),
        'ffn_w_up': nrm(ks[12], (DEPTH, 2, D_MODEL, D_FF), D_MODEL ** -0.5),
        'ffn_w_down': nrm(ks[13], (DEPTH, 2, D_FF, D_MODEL), D_FF ** -0.5),
        'a_w_in': nrm(ks[14], (N_A, D_MODEL, 2 * D_A), D_MODEL ** -0.5),
        'a_norm_g': 1.0 + nrm(ks[15], (N_A, D_A), 0.02),
        'a_w_s': nrm(ks[16], (N_A, G_A, CHUNK, CHUNK), CHUNK ** -0.5),
        'a_b_s': 1.0 + nrm(ks[17], (N_A, G_A, CHUNK), 0.1),
        'a_w_out': nrm(ks[18], (N_A, D_A, D_MODEL), D_A ** -0.5),
        'b_w_qkv': nrm(ks[19], (N_B, D_MODEL, qkv_b), D_MODEL ** -0.5),
        'b_q_g': 1.0 + nrm(ks[20], (N_B, HD_B), 0.02),
        'b_k_g': 1.0 + nrm(ks[21], (N_B, HD_B), 0.02),
        'b_w_out': nrm(ks[22], (N_B, HQ_B * HD_B, D_MODEL), (HQ_B * HD_B) ** -0.5),
        'c_w_qkv': nrm(ks[23], (N_C, D_MODEL, qkv_c), D_MODEL ** -0.5),
        'c_sink': nrm(ks[24], (N_C, HQ_C), 0.5),
        'c_w_out': nrm(ks[25], (N_C, HQ_C * HD_C, D_MODEL), (HQ_C * HD_C) ** -0.5),
        'final_g': 1.0 + nrm(ks[26], (D_MODEL,), 0.02),
    }


def reference(x_prompt, x_sample, cache_b_k, cache_b_v, cache_c_k, cache_c_v, c, c_ctx,
              w_mod, b_mod, norm_g, ffn_w_gate, ffn_w_up, ffn_w_down,
              a_w_in, a_norm_g, a_w_s, a_b_s, a_w_out,
              b_w_qkv, b_q_g, b_k_g, b_w_out,
              c_w_qkv, c_sink, c_w_out, final_g):
    xp, xs = x_prompt, x_sample
    nbk, nbv, nck, ncv = [], [], [], []
    for l in range(DEPTH):
        kind, idx = l % N_MIXERS, l // N_MIXERS
        mp = ada_params(c_ctx[None, :], w_mod[l], b_mod[l])
        ms = ada_params(c, w_mod[l], b_mod[l])
        f0 = (ffn_w_gate[l, 0], ffn_w_up[l, 0], ffn_w_down[l, 0])
        xp = ffn_half_step(xp, mp, 0, norm_g[l, 0], *f0)
        xs = ffn_half_step(xs, ms, 0, norm_g[l, 0], *f0)
        hp = modulate(rmsnorm(xp, norm_g[l, 1]), mp[:, 3], mp[:, 4])
        hs = modulate(rmsnorm(xs, norm_g[l, 1]), ms[:, 3], ms[:, 4])
        if kind == 0:
            a = (a_w_in[idx], a_norm_g[idx], a_w_s[idx], a_b_s[idx], a_w_out[idx])
            op = chunk_gating_mlp(hp, *a)
            os_ = chunk_gating_mlp(hs, *a)
        elif kind == 1:
            op, kp, vp = full_attn_context(hp, b_w_qkv[idx], b_q_g[idx], b_k_g[idx], b_w_out[idx])
            nbk.append(kp)
            nbv.append(vp)
            os_ = full_attn_latent(hs, cache_b_k[:, idx], cache_b_v[:, idx], b_w_qkv[idx], b_q_g[idx], b_k_g[idx], b_w_out[idx])
        else:
            op, kp, vp = window_attn_context(hp, c_w_qkv[idx], c_sink[idx], c_w_out[idx])
            nck.append(kp)
            ncv.append(vp)
            os_ = window_attn_latent(hs, cache_c_k[:, idx], cache_c_v[:, idx], c_w_qkv[idx], c_sink[idx], c_w_out[idx])
        xp = xp + mp[:, 5][:, None, :] * op
        xs = xs + ms[:, 5][:, None, :] * os_
        f1 = (ffn_w_gate[l, 1], ffn_w_up[l, 1], ffn_w_down[l, 1])
        xp = ffn_half_step(xp, mp, 6, norm_g[l, 2], *f1)
        xs = ffn_half_step(xs, ms, 6, norm_g[l, 2], *f1)
    y_prompt = rmsnorm(xp, final_g)
    y_sample = rmsnorm(xs, final_g)
    new_b_k = jnp.stack(nbk, axis=1)
    new_b_v = jnp.stack(nbv, axis=1)
    new_c_k = jnp.stack(nck, axis=1)
    new_c_v = jnp.stack(ncv, axis=1)
    return (y_prompt, y_sample, new_b_k, new_b_v, new_c_k, new_c_v)
```

```cpp
#include <hip/hip_runtime.h>
#include <hip/hip_cooperative_groups.h>
#include <cstdio>
#include <cstdint>
namespace cg = cooperative_groups;
namespace pg8 {
#define PG8_LAS __attribute__((address_space(3)))
typedef unsigned short bf16_t;
typedef short bf16x8 __attribute__((ext_vector_type(8)));
typedef float f32x4 __attribute__((ext_vector_type(4)));
typedef unsigned u32x4 __attribute__((ext_vector_type(4)));
constexpr int BM = 256, BK = 64, HALF = 128, HTB = HALF * BK * 2  , STAGE_BYTES = 8 * HTB, NXCD = 8, WGM = 8;

__host__ __device__ __forceinline__ int lds_byte(int r, int c) { const int st = (r >> 4) * 2 + (c >> 5), rr = r & 15, cc = c & 31, ob = rr * 64 + cc * 2; return st * 1024 + (ob ^ (((ob >> 9) & 1) << 5)); }
__host__ __device__ __forceinline__ void stage_rc(int b, int& R, int& C) { const int st = b / 1024, sb = b % 1024, swz = sb ^ (((sb >> 9) & 1) << 5); R = (st >> 1) * 16 + swz / 64; C = (st & 1) * 32 + (swz % 64) / 2; }
__host__ __device__ __forceinline__ int perm32(int rho) { const int n = rho >> 4, i = rho & 15; return 8 * (i >> 2) + 4 * n + (i & 3); }

struct Unit { int pm, pn; };
struct Gemm { const bf16_t* A; const bf16_t* Bt; int M, N, K; };

struct StaticOrder {
    int nM, nN, nwg, G, c;
    __host__ __device__ void init(int M, int N, int G_, int c_) { nM = M / BM; nN = N / BM; nwg = nM * nN; G = G_; c = c_; }
    __host__ __device__ bool next(int i, Unit& u) const {
        const long L = (long)i * G + c; if (L >= nwg) return false;
        int wgid = (int)L; { const int q = nwg / NXCD, r = nwg % NXCD, xcd = wgid % NXCD, off = wgid / NXCD; wgid = (xcd < r ? xcd * (q + 1) : r * (q + 1) + (xcd - r) * q) + off; }
        const int nig = WGM * nN, gid = wgid / nig, fm = gid * WGM, gsz = (nM - fm) < WGM ? (nM - fm) : WGM;
        u.pm = fm + ((wgid % nig) % gsz); u.pn = (wgid % nig) / gsz; return true;
    }
    __device__ __forceinline__ void a_ready(const Unit&) const {}
    __device__ __forceinline__ void done(const Unit&) const {}
};

__device__ __forceinline__ unsigned cvt_pk_bf16(float lo, float hi) { unsigned r; asm volatile("v_cvt_pk_bf16_f32 %0, %1, %2" : "=v"(r) : "v"(lo), "v"(hi)); return r; }
typedef float f32x2 __attribute__((ext_vector_type(2)));
__device__ __forceinline__ f32x2 gelu_pk(f32x2 v) {
    const f32x2 av = __builtin_elementwise_abs(v), d = av * 0.2316418882f + 1.0f;
    f32x2 t; t.x = __builtin_amdgcn_rcpf(d.x); t.y = __builtin_amdgcn_rcpf(d.y);
    f32x2 q = t * 0.5307027145f + (-0.7265760135f); q = q * t + 0.7107068705f; q = q * t + (-0.142248368f); q = q * t + 0.127414796f; q = q * t;
    const f32x2 s = (v * v) * (-0.72134752044f);
    f32x2 e; e.x = __builtin_amdgcn_exp2f(s.x); e.y = __builtin_amdgcn_exp2f(s.y);
    const f32x2 m = v * (q * e), r = v - m;
    f32x2 o; o.x = v.x < 0.f ? m.x : r.x; o.y = v.y < 0.f ? m.y : r.y; return o;
}

template <int ACT  > struct EpiBf16 {
    static constexpr bool PERM = true, AFTER_DRAIN = false; static_assert(ACT == 0 || ACT == 1, "EpiBf16: ACT is 0 (none) or 1 (gelu_pk)");
    bf16_t* O; int ldc; const float* bias; int split_cols; size_t split_stride; float scale0;
    __device__ __forceinline__ void operator()(const f32x4 (&acc)[2][2][4][2], const Unit& u, int wr, int wc, int fr, int fq) const {
        const int row0 = u.pm * BM + wr * 64 + fr; int colt = u.pn * BM; bf16_t* base = O;
        float sc = 1.f; if (split_cols) { const int t = colt / split_cols; base += (size_t)t * split_stride; colt -= t * split_cols; if (t == 0) sc = scale0; }
        const int col0 = colt + wc * 32 + 8 * fq, bcol0 = u.pn * BM + wc * 32 + 8 * fq;
        f32x4 bv[2][2];
#pragma unroll
        for (int bj = 0; bj < 2; ++bj)
#pragma unroll
            for (int n = 0; n < 2; ++n) bv[bj][n] = bias ? *(const f32x4*)(bias + bcol0 + bj * HALF + 4 * n) : (f32x4){0.f, 0.f, 0.f, 0.f};
#pragma unroll
        for (int ai = 0; ai < 2; ++ai)
#pragma unroll
            for (int m = 0; m < 4; ++m) { bf16_t* rowp = base + (size_t)(row0 + ai * HALF + m * 16) * ldc + col0;
#pragma unroll
                for (int bj = 0; bj < 2; ++bj) { f32x4 v0 = acc[ai][bj][m][0] + bv[bj][0], v1 = acc[ai][bj][m][1] + bv[bj][1];
                    if (ACT == 1) { f32x2 a = gelu_pk((f32x2){v0[0], v0[1]}), b = gelu_pk((f32x2){v0[2], v0[3]}), c = gelu_pk((f32x2){v1[0], v1[1]}), d = gelu_pk((f32x2){v1[2], v1[3]});
                        v0 = (f32x4){a.x, a.y, b.x, b.y}; v1 = (f32x4){c.x, c.y, d.x, d.y}; }
                    v0 = v0 * sc; v1 = v1 * sc; u32x4 w; w.x = cvt_pk_bf16(v0[0], v0[1]); w.y = cvt_pk_bf16(v0[2], v0[3]); w.z = cvt_pk_bf16(v1[0], v1[1]); w.w = cvt_pk_bf16(v1[2], v1[3]);
                    *(u32x4*)(rowp + bj * HALF) = w; } }
    }
};
template <class Epi, class Sched, bool ALIGN_EPI = false, bool SP2 = false>
__device__ __forceinline__ void gemm_phase(PG8_LAS unsigned char* lds, const Gemm g, const Sched& S, const Epi& E, const int tid) {
    const int wid = __builtin_amdgcn_readfirstlane(tid >> 6), lane = tid & 63, wr = wid >> 2, wc = wid & 3, fr = lane & 15, fq = lane >> 4;
    const int K = g.K, nt = K / BK;
    unsigned voffA[2], voffB[2];
#pragma unroll
    for (int i = 0; i < 2; ++i) { int R, C; stage_rc(tid * 16 + i * 8192, R, C); const int Rb = Epi::PERM ? ((R & ~31) + perm32(R & 31)) : R;
        voffA[i] = (unsigned)(R * K + C) * 2u; voffB[i] = (unsigned)(Rb * K + C) * 2u; }
    const size_t kstep = (size_t)(BK * 2);
    const size_t hstep = (size_t)HALF * K * 2;
    const size_t tstep = 2 * hstep;
    const unsigned ldsw = (unsigned)wid * 1024u;
    const int aoff = lds_byte(wr * 64 + fr, fq * 8), boff = lds_byte(wc * 32 + fr, fq * 8);
#define PG8_SA(b, h) (((b) * 2 + (h)) * HTB)
#define PG8_SB(b, h) ((4 + (b) * 2 + (h)) * HTB)
#define PG8_STAGE(bufoff, gbase, voff) do { _Pragma("unroll") for (int _i = 0; _i < 2; ++_i) \
        __builtin_amdgcn_global_load_lds((const unsigned*)((const char*)(gbase) + (voff)[_i]), (PG8_LAS unsigned*)(lds + (bufoff) + ldsw + _i * 8192), 16, 0, 0); } while (0)
#define PG8_LDA(dst, b, h) do { _Pragma("unroll") for (int m = 0; m < 4; ++m) _Pragma("unroll") for (int k = 0; k < 2; ++k) dst[m][k] = *(const PG8_LAS bf16x8*)(lds + PG8_SA(b, h) + aoff + m * 2048 + k * 1024); } while (0)
#define PG8_LDB(dst, b, h) do { _Pragma("unroll") for (int n = 0; n < 2; ++n) _Pragma("unroll") for (int k = 0; k < 2; ++k) dst[n][k] = *(const PG8_LAS bf16x8*)(lds + PG8_SB(b, h) + boff + n * 2048 + k * 1024); } while (0)
#define PG8_MMA(ai, bj, At, Bt) do { __builtin_amdgcn_s_setprio(1); _Pragma("unroll") for (int m = 0; m < 4; ++m) _Pragma("unroll") for (int n = 0; n < 2; ++n) _Pragma("unroll") for (int k = 0; k < 2; ++k) \
        acc[ai][bj][m][n] = __builtin_amdgcn_mfma_f32_16x16x32_bf16(Bt[n][k], At[m][k], acc[ai][bj][m][n], 0, 0, 0); __builtin_amdgcn_s_setprio(0); } while (0)
#define PG8_WAIT_V(n) asm volatile("s_waitcnt vmcnt(" #n ")" ::: "memory")
#define PG8_WAIT_L(n) asm volatile("s_waitcnt lgkmcnt(" #n ")" ::: "memory")
#define PG8_BAR __builtin_amdgcn_s_barrier()
#define PG8_SCHED __builtin_amdgcn_sched_barrier(0)
    Unit cur, nxt; int ui = 0;
    if (!S.next(0, cur)) return;
    f32x4 acc[2][2][4][2];
#pragma unroll
    for (int a = 0; a < 2; ++a)
#pragma unroll
        for (int b = 0; b < 2; ++b)
#pragma unroll
            for (int m = 0; m < 4; ++m)
#pragma unroll
                for (int n = 0; n < 2; ++n) acc[a][b][m][n] = (f32x4){0.f, 0.f, 0.f, 0.f};
    bf16x8 At[4][2], B0[2][2], B1[2][2];
    const char* cA = (const char*)g.A + (size_t)cur.pm * tstep; const char* cB = (const char*)g.Bt + (size_t)cur.pn * tstep;
    S.a_ready(cur);
    if constexpr (SP2) {
        PG8_STAGE(PG8_SB(0, 0), cB, voffB); PG8_STAGE(PG8_SB(0, 1), cB + hstep, voffB); PG8_STAGE(PG8_SA(0, 0), cA, voffA); PG8_STAGE(PG8_SA(0, 1), cA + hstep, voffA);
        if (wr == 1) PG8_BAR;
        PG8_WAIT_V(2); PG8_BAR;
        PG8_STAGE(PG8_SB(1, 0), cB + kstep, voffB); PG8_STAGE(PG8_SA(1, 0), cA + kstep, voffA); PG8_STAGE(PG8_SB(1, 1), cB + hstep + kstep, voffB);
        PG8_WAIT_V(6); PG8_BAR;
    } else {
        PG8_STAGE(PG8_SB(0, 0), cB, voffB); PG8_STAGE(PG8_SA(0, 0), cA, voffA); PG8_STAGE(PG8_SB(0, 1), cB + hstep, voffB); PG8_STAGE(PG8_SA(0, 1), cA + hstep, voffA);
        if (wr == 1) PG8_BAR;
        PG8_WAIT_V(4); PG8_BAR;
        PG8_STAGE(PG8_SB(1, 0), cB + kstep, voffB); PG8_STAGE(PG8_SA(1, 0), cA + kstep, voffA); PG8_STAGE(PG8_SB(1, 1), cB + hstep + kstep, voffB);
        PG8_WAIT_V(6); PG8_BAR;
    }
    for (;;) {
        const bool has_next = S.next(ui + 1, nxt);
        const char* nA = has_next ? (const char*)g.A + (size_t)nxt.pm * tstep : cA; const char* nB = has_next ? (const char*)g.Bt + (size_t)nxt.pn * tstep : cB;
        for (int t = 0; t < nt; t += 2) {
            const bool last = (t == nt - 2);
            const char* a1 = cA + (size_t)(t + 1) * kstep;
            const char* a2 = last ? nA : cA + (size_t)(t + 2) * kstep; const char* b2 = last ? nB : cB + (size_t)(t + 2) * kstep;
            const char* a3 = a2 + kstep; const char* b3 = b2 + kstep;
            if (last && has_next) S.a_ready(nxt);
            if constexpr (SP2) {
            PG8_LDB(B0, 0, 0); PG8_LDB(B1, 0, 1); PG8_SCHED; PG8_LDA(At, 0, 0); PG8_STAGE(PG8_SA(1, 1), a1 + hstep, voffA);
            PG8_WAIT_V(8); PG8_WAIT_L(0); PG8_BAR; PG8_MMA(0, 0, At, B0); PG8_MMA(0, 1, At, B1); PG8_BAR; PG8_SCHED;
            PG8_LDA(At, 0, 1); PG8_STAGE(PG8_SB(0, 0), b2, voffB); PG8_STAGE(PG8_SB(0, 1), b2 + hstep, voffB); PG8_STAGE(PG8_SA(0, 0), a2, voffA);
            PG8_WAIT_V(8); PG8_WAIT_L(0); PG8_BAR; PG8_MMA(1, 0, At, B0); PG8_MMA(1, 1, At, B1); PG8_BAR; PG8_SCHED;
            PG8_LDB(B0, 1, 0); PG8_LDB(B1, 1, 1); PG8_SCHED; PG8_LDA(At, 1, 0); PG8_STAGE(PG8_SA(0, 1), a2 + hstep, voffA);
            PG8_WAIT_V(8); PG8_WAIT_L(0); PG8_BAR; PG8_MMA(0, 0, At, B0); PG8_MMA(0, 1, At, B1); PG8_BAR; PG8_SCHED;
            PG8_LDA(At, 1, 1); PG8_STAGE(PG8_SB(1, 0), b3, voffB); PG8_STAGE(PG8_SB(1, 1), b3 + hstep, voffB); PG8_STAGE(PG8_SA(1, 0), a3, voffA);
            PG8_WAIT_V(8); PG8_WAIT_L(0); PG8_BAR; PG8_MMA(1, 0, At, B0); PG8_MMA(1, 1, At, B1); PG8_BAR; PG8_SCHED;
            } else {
            PG8_LDB(B0, 0, 0); PG8_SCHED; PG8_LDA(At, 0, 0); PG8_STAGE(PG8_SA(1, 1), a1 + hstep, voffA);
            PG8_WAIT_L(8); PG8_BAR; PG8_WAIT_L(0); PG8_MMA(0, 0, At, B0); PG8_BAR; PG8_SCHED;
            PG8_LDB(B1, 0, 1); PG8_STAGE(PG8_SB(0, 0), b2, voffB);
            PG8_BAR; PG8_WAIT_L(0); PG8_MMA(0, 1, At, B1); PG8_BAR;
            PG8_LDA(At, 0, 1); PG8_STAGE(PG8_SA(0, 0), a2, voffA);
            PG8_BAR; PG8_WAIT_L(0); PG8_MMA(1, 0, At, B0); PG8_BAR; PG8_SCHED;
            PG8_STAGE(PG8_SB(0, 1), b2 + hstep, voffB);
            PG8_WAIT_V(6); PG8_BAR; PG8_MMA(1, 1, At, B1); PG8_BAR;
            PG8_LDB(B0, 1, 0); PG8_SCHED; PG8_LDA(At, 1, 0); PG8_STAGE(PG8_SA(0, 1), a2 + hstep, voffA);
            PG8_WAIT_L(8); PG8_BAR; PG8_WAIT_L(0); PG8_MMA(0, 0, At, B0); PG8_BAR; PG8_SCHED;
            PG8_LDB(B1, 1, 1); PG8_STAGE(PG8_SB(1, 0), b3, voffB);
            PG8_BAR; PG8_WAIT_L(0); PG8_MMA(0, 1, At, B1); PG8_BAR;
            PG8_LDA(At, 1, 1); PG8_STAGE(PG8_SA(1, 0), a3, voffA);
            PG8_BAR; PG8_WAIT_L(0); PG8_MMA(1, 0, At, B0); PG8_BAR; PG8_SCHED;
            PG8_STAGE(PG8_SB(1, 1), b3 + hstep, voffB);
            PG8_WAIT_V(6); PG8_BAR; PG8_MMA(1, 1, At, B1); PG8_BAR;
            }
        }
        if constexpr (ALIGN_EPI) { if (wr == 0) PG8_BAR; }
        if constexpr (!Epi::AFTER_DRAIN) { E(acc, cur, wr, wc, fr, fq); S.done(cur); }
        if (!has_next) break;
#pragma unroll
        for (int a = 0; a < 2; ++a)
#pragma unroll
            for (int b = 0; b < 2; ++b)
#pragma unroll
                for (int m = 0; m < 4; ++m)
#pragma unroll
                    for (int n = 0; n < 2; ++n) acc[a][b][m][n] = (f32x4){0.f, 0.f, 0.f, 0.f};
        cur = nxt; cA = nA; cB = nB; ++ui;
        if constexpr (ALIGN_EPI) { if (wr == 1) PG8_BAR; }
    }
    PG8_WAIT_V(0);
    if constexpr (!ALIGN_EPI) { if (wr == 0) PG8_BAR; }
    PG8_BAR;
    if constexpr (Epi::AFTER_DRAIN) { E.fused(acc, cur, wr, wc, fr, fq, lds, wid, lane); S.done(cur); }
#undef PG8_SA
#undef PG8_SB
#undef PG8_STAGE
#undef PG8_LDA
#undef PG8_LDB
#undef PG8_MMA
#undef PG8_WAIT_V
#undef PG8_WAIT_L
#undef PG8_BAR
#undef PG8_SCHED
}
}
namespace pg8 {
struct EpiSwiGLU {
    static constexpr bool PERM = false, AFTER_DRAIN = false;
    bf16_t* O; int ldc;
    __device__ __forceinline__ void operator()(const f32x4 (&acc)[2][2][4][2], const Unit& u, int wr, int wc, int fr, int fq) const {
        const int row0 = u.pm * BM + wr * 64 + fr;
#pragma unroll
        for (int ai = 0; ai < 2; ++ai)
#pragma unroll
            for (int m = 0; m < 4; ++m) {
                bf16_t* rowp = O + (size_t)(row0 + ai * HALF + m * 16) * ldc;
#pragma unroll
                for (int bj = 0; bj < 2; ++bj) {
                    const int f = 16 * (8 * u.pn + 4 * bj + wc) + 4 * fq;
                    const f32x4 g = acc[ai][bj][m][0], up = acc[ai][bj][m][1];
                    float a[4];
#pragma unroll
                    for (int i = 0; i < 4; ++i) a[i] = g[i] * __builtin_amdgcn_rcpf(1.0f + __expf(-g[i])) * up[i];
                    typedef unsigned u32x2 __attribute__((ext_vector_type(2)));
                    u32x2 w; w.x = cvt_pk_bf16(a[0], a[1]); w.y = cvt_pk_bf16(a[2], a[3]);
                    *(u32x2*)(rowp + f) = w;
                }
            }
    }
};
struct EpiRes {
    static constexpr bool PERM = false, AFTER_DRAIN = false;
    float* X; const float* modl; int k; float s;
    __device__ __forceinline__ void operator()(const f32x4 (&acc)[2][2][4][2], const Unit& u, int wr, int wc, int fr, int fq) const {
        const int r = u.pm < 16 ? 0 : 1 + ((u.pm - 16) >> 4);
        const float* cf = modl + (size_t)(r * 9 + k) * 1024;
        const int col0 = u.pn * BM + wc * 32 + 4 * fq;
        f32x4 cv[2][2];
#pragma unroll
        for (int bj = 0; bj < 2; ++bj)
#pragma unroll
            for (int n = 0; n < 2; ++n) cv[bj][n] = *(const f32x4*)(cf + col0 + bj * HALF + n * 16) * s;
        const int row0 = u.pm * BM + wr * 64 + fr;
#pragma unroll
        for (int ai = 0; ai < 2; ++ai)
#pragma unroll
            for (int m = 0; m < 4; ++m) {
                float* rowp = X + (size_t)(row0 + ai * HALF + m * 16) * 1024 + col0;
#pragma unroll
                for (int bj = 0; bj < 2; ++bj)
#pragma unroll
                    for (int n = 0; n < 2; ++n) { f32x4* p = (f32x4*)(rowp + bj * HALF + n * 16); *p = *p + cv[bj][n] * acc[ai][bj][m][n]; }
            }
    }
};
struct EpiBf16N {
    static constexpr bool PERM = false, AFTER_DRAIN = false;
    bf16_t* O; int ldc; float* SS; int sspn;
    __device__ __forceinline__ void operator()(const f32x4 (&acc)[2][2][4][2], const Unit& u, int wr, int wc, int fr, int fq) const {
        typedef unsigned u32x2 __attribute__((ext_vector_type(2)));
        const int row0 = u.pm * BM + wr * 64 + fr; const int col0 = u.pn * BM + wc * 32 + 4 * fq;
        const bool isv = SS != nullptr && u.pn >= sspn;
#pragma unroll
        for (int ai = 0; ai < 2; ++ai)
#pragma unroll
            for (int m = 0; m < 4; ++m) {
                const int row = row0 + ai * HALF + m * 16;
                bf16_t* rowp = O + (size_t)row * ldc + col0; float ss = 0.f;
#pragma unroll
                for (int bj = 0; bj < 2; ++bj)
#pragma unroll
                    for (int n = 0; n < 2; ++n) { const f32x4 v = acc[ai][bj][m][n];
                        ss += (v[0] * v[0] + v[1] * v[1]) + (v[2] * v[2] + v[3] * v[3]);
                        u32x2 w; w.x = cvt_pk_bf16(v[0], v[1]); w.y = cvt_pk_bf16(v[2], v[3]);
                        *(u32x2*)(rowp + bj * HALF + n * 16) = w; }
                if (isv) { ss += __shfl_xor(ss, 16); ss += __shfl_xor(ss, 32); if (fq == 0) atomicAdd(SS + row, ss); }
            }
    }
};
}

#define LAS __attribute__((address_space(3)))
typedef unsigned short bf16;
typedef unsigned v4u __attribute__((ext_vector_type(4)));
typedef unsigned v2u __attribute__((ext_vector_type(2)));
typedef float f32x4 __attribute__((ext_vector_type(4)));
typedef float f32x16 __attribute__((ext_vector_type(16)));
typedef short bf16x8 __attribute__((ext_vector_type(8)));
typedef short s16x4 __attribute__((ext_vector_type(4)));

constexpr int D = 1024, MP = 4096, MS = 16384, M = MP + MS, FF = 2816, NTHR = 512, NWAVES = 8;
constexpr float EPS = 1e-6f;
constexpr float LOG2E = 1.4426950408889634f;
constexpr int LDS_BYTES = 147456;

constexpr size_t MiB = 1u << 20;
constexpr size_t OFF_CTL = 0;
constexpr size_t OFF_MOD = 1 * MiB;
constexpr size_t OFF_SS = 2 * MiB;
constexpr size_t OFF_WSS = 3 * MiB;
constexpr size_t OFF_WGU = 4 * MiB;
constexpr size_t SZ_WGU = (size_t)5632 * 1024 * 2;
constexpr size_t OFF_WD = OFF_WGU + 8 * SZ_WGU;
constexpr size_t SZ_WD = (size_t)1024 * 2816 * 2;
constexpr size_t OFF_WAIN = OFF_WD + 8 * SZ_WD;
constexpr size_t SZ_WAIN = (size_t)4096 * 1024 * 2;
constexpr size_t OFF_WAOUT = OFF_WAIN + 2 * SZ_WAIN;
constexpr size_t SZ_WAOUT = (size_t)1024 * 2048 * 2;
constexpr size_t OFF_WBQKV = OFF_WAOUT + 2 * SZ_WAOUT;
constexpr size_t OFF_WBOUT = OFF_WBQKV + (size_t)1536 * 1024 * 2;
constexpr size_t OFF_WCQKV = OFF_WBOUT + (size_t)1024 * 1024 * 2;
constexpr size_t OFF_WCOUT = OFF_WCQKV + (size_t)1280 * 1024 * 2;
constexpr size_t OFF_H = OFF_WCOUT + (size_t)1024 * 1024 * 2;
constexpr size_t OFF_ACT = OFF_H + (size_t)M * 2048 * 2;
constexpr size_t OFF_KL = OFF_ACT + (size_t)M * 4096 * 2;
constexpr size_t SZ_KL = (size_t)4 * 2 * 4608 * 128 * 2;
constexpr size_t OFF_VL = OFF_KL + SZ_KL;
constexpr size_t OFF_KP = OFF_VL + SZ_KL;
constexpr size_t SZ_KPP = (size_t)16 * 2 * 256 * 128 * 2;
constexpr size_t OFF_VP = OFF_KP + SZ_KPP;
constexpr size_t WS_END = OFF_VP + SZ_KPP;
static_assert(OFF_WGU % 256 == 0 && OFF_H % 256 == 0 && OFF_ACT % 256 == 0 && OFF_KL % 256 == 0, "align");

constexpr size_t OUT_BK = (size_t)M * D, OUT_BV = OUT_BK + 16 * 256 * 2 * 128, OUT_CK = OUT_BV + 16 * 256 * 2 * 128, OUT_CV = OUT_CK + 16 * 256 * 2 * 64;

struct Args { const float* in[27]; float* out; unsigned char* ws; };

__device__ __forceinline__ unsigned f2bf(float f) { unsigned u = __builtin_bit_cast(unsigned, f); return (u + 0x7fffu + ((u >> 16) & 1u)) >> 16; }
__device__ __forceinline__ unsigned pk2(float lo, float hi) { return pg8::cvt_pk_bf16(lo, hi); }
__device__ __forceinline__ float bflo(unsigned w) { return __builtin_bit_cast(float, w << 16); }
__device__ __forceinline__ float bfhi(unsigned w) { return __builtin_bit_cast(float, w & 0xffff0000u); }
__device__ __forceinline__ float wave_sum(float v) {
#pragma unroll
    for (int o = 1; o < 64; o <<= 1) v += __shfl_xor(v, o);
    return v;
}
__device__ __forceinline__ int modrow(int row) { return row < MP ? 0 : 1 + ((row - MP) >> 12); }

__device__ __forceinline__ void transpose_item(const float* W, int K, int N, bf16* WT, int mode, LAS float* scr, int item, int lane) {
    const int nblk = N / 32, kb = item / nblk, nb = item % nblk, k0 = 64 * kb, n0 = 32 * nb;
#pragma unroll 8
    for (int i = 0; i < 32; ++i) { const int kk = 2 * i + (lane >> 5); scr[kk * 33 + (lane & 31)] = W[(size_t)(k0 + kk) * N + n0 + (lane & 31)]; }
    asm volatile("s_waitcnt lgkmcnt(0)" ::: "memory");
    const int c = lane & 7;
#pragma unroll
    for (int j = 0; j < 4; ++j) { const int n = (lane >> 3) + 8 * j; const LAS float* s = scr + (8 * c) * 33 + n;
        v4u o; o.x = pk2(s[0 * 33], s[1 * 33]); o.y = pk2(s[2 * 33], s[3 * 33]); o.z = pk2(s[4 * 33], s[5 * 33]); o.w = pk2(s[6 * 33], s[7 * 33]);
        const int nn = n0 + n; const int np = mode == 0 ? nn : ((nn >> 4) * 32 + (nn & 15) + (mode == 2 ? 16 : 0));
        *(v4u*)(WT + (size_t)np * K + k0 + 8 * c) = o; }
    asm volatile("s_waitcnt lgkmcnt(0)" ::: "memory");
}
constexpr int IT_GU = 16 * 88, IT_D = 44 * 32, IT_AIN = 16 * 128, IT_AOUT = 32 * 32, IT_BQKV = 16 * 48, IT_O = 16 * 32, IT_CQKV = 16 * 40;
constexpr int NIT = 16 * IT_GU + 8 * IT_D + 2 * IT_AIN + 2 * IT_AOUT + IT_BQKV + IT_O + IT_CQKV + IT_O;
__device__ __forceinline__ void conv_item(const Args& a, int it, LAS float* scr, int lane) {
    unsigned char* ws = a.ws; int r = it;
    if (r < 16 * IT_GU) { const int mat = r / IT_GU, ls = mat >> 1, up = mat & 1; r -= mat * IT_GU;
        transpose_item(a.in[up ? 12 : 11] + (size_t)ls * 1024 * FF, 1024, FF, (bf16*)(ws + OFF_WGU + ls * SZ_WGU), 1 + up, scr, r, lane); return; }
    r -= 16 * IT_GU;
    if (r < 8 * IT_D) { const int ls = r / IT_D; r -= ls * IT_D; transpose_item(a.in[13] + (size_t)ls * FF * 1024, FF, 1024, (bf16*)(ws + OFF_WD + ls * SZ_WD), 0, scr, r, lane); return; }
    r -= 8 * IT_D;
    if (r < 2 * IT_AIN) { const int i = r / IT_AIN; r -= i * IT_AIN; transpose_item(a.in[14] + (size_t)i * 1024 * 4096, 1024, 4096, (bf16*)(ws + OFF_WAIN + i * SZ_WAIN), 0, scr, r, lane); return; }
    r -= 2 * IT_AIN;
    if (r < 2 * IT_AOUT) { const int i = r / IT_AOUT; r -= i * IT_AOUT; transpose_item(a.in[18] + (size_t)i * 2048 * 1024, 2048, 1024, (bf16*)(ws + OFF_WAOUT + i * SZ_WAOUT), 0, scr, r, lane); return; }
    r -= 2 * IT_AOUT;
    if (r < IT_BQKV) { transpose_item(a.in[19], 1024, 1536, (bf16*)(ws + OFF_WBQKV), 0, scr, r, lane); return; }
    r -= IT_BQKV;
    if (r < IT_O) { transpose_item(a.in[22], 1024, 1024, (bf16*)(ws + OFF_WBOUT), 0, scr, r, lane); return; }
    r -= IT_O;
    if (r < IT_CQKV) { transpose_item(a.in[23], 1024, 1280, (bf16*)(ws + OFF_WCQKV), 0, scr, r, lane); return; }
    r -= IT_CQKV;
    transpose_item(a.in[25], 1024, 1024, (bf16*)(ws + OFF_WCOUT), 0, scr, r, lane);
}
__device__ __forceinline__ void mod_items(const Args& a, LAS unsigned char* lds, int tid, int lane, int wave) {
    LAS float* sc = (LAS float*)lds;
    LAS float* red = (LAS float*)(lds + 20480);
    float* mod = (float*)(a.ws + OFF_MOD);
    if ((int)blockIdx.x >= 144) return;
    for (int i = tid; i < 5 * 1024; i += NTHR) { const int r = i >> 10, k = i & 1023; const float v = r == 0 ? a.in[7][k] : a.in[6][(r - 1) * 1024 + k]; sc[i] = v / (1.0f + __expf(-v)); }
    __syncthreads();
    for (int item = blockIdx.x; item < 144; item += gridDim.x) {
        const int l = item / 36, cgp = item % 36; const int n0 = cgp * 256 + 4 * lane;
        const float* wp = a.in[8] + ((size_t)l * 1024 + wave * 128) * 9216 + n0;
        f32x4 acc[5];
#pragma unroll
        for (int r = 0; r < 5; ++r) acc[r] = (f32x4){0.f, 0.f, 0.f, 0.f};
#pragma unroll 8
        for (int kk = 0; kk < 128; ++kk) { const f32x4 wv = *(const f32x4*)(wp + (size_t)kk * 9216);
#pragma unroll
            for (int r = 0; r < 5; ++r) acc[r] += wv * sc[r * 1024 + wave * 128 + kk]; }
#pragma unroll
        for (int r = 0; r < 5; ++r) *(LAS f32x4*)(red + (wave * 5 + r) * 256 + 4 * lane) = acc[r];
        __syncthreads();
        for (int idx = tid; idx < 5 * 256; idx += NTHR) { const int r = idx >> 8, c = idx & 255; float s = a.in[9][l * 9216 + cgp * 256 + c];
#pragma unroll
            for (int w = 0; w < 8; ++w) s += red[(w * 5 + r) * 256 + c];
            mod[(size_t)(l * 5 + r) * 9216 + cgp * 256 + c] = s; }
        __syncthreads();
    }
}
template <bool FIRST> __device__ __forceinline__ void norm_phase(const Args& a, int l, int k, int gw, int NGW, int lane) {
    const float* g = a.in[10] + (l * 3 + k) * 1024; const float* mod = (const float*)(a.ws + OFF_MOD) + (size_t)l * 5 * 9216;
    float* X = a.out; bf16* H = (bf16*)(a.ws + OFF_H);
    for (int row = gw; row < M; row += NGW) {
        const float* src = FIRST ? (row < MP ? a.in[0] + (size_t)row * D : a.in[1] + (size_t)(row - MP) * D) : X + (size_t)row * D;
        f32x4 v[4]; float s = 0.f;
#pragma unroll
        for (int j = 0; j < 4; ++j) { v[j] = *(const f32x4*)(src + 4 * lane + 256 * j); s += (v[j].x * v[j].x + v[j].y * v[j].y) + (v[j].z * v[j].z + v[j].w * v[j].w); }
        const float rstd = rsqrtf(wave_sum(s) * (1.0f / D) + EPS);
        const float* sh = mod + (size_t)(modrow(row) * 9 + 3 * k) * 1024; const float* sc = sh + 1024;
#pragma unroll
        for (int j = 0; j < 4; ++j) { const int c = 4 * lane + 256 * j; const f32x4 gg = *(const f32x4*)(g + c), s4 = *(const f32x4*)(sh + c), c4 = *(const f32x4*)(sc + c);
            const f32x4 y = v[j] * rstd * gg * (c4 + 1.0f) + s4; v2u o; o.x = pk2(y.x, y.y); o.y = pk2(y.z, y.w);
            *(v2u*)(H + (size_t)row * 1024 + c) = o;
            if (FIRST) *(f32x4*)(X + (size_t)row * D + c) = v[j]; }
    }
}
__device__ __forceinline__ void final_norm(const Args& a, int gw, int NGW, int lane) {
    const float* g = a.in[26]; float* X = a.out;
    for (int row = gw; row < M; row += NGW) {
        f32x4 v[4]; float s = 0.f;
#pragma unroll
        for (int j = 0; j < 4; ++j) { v[j] = *(const f32x4*)(X + (size_t)row * D + 4 * lane + 256 * j); s += (v[j].x * v[j].x + v[j].y * v[j].y) + (v[j].z * v[j].z + v[j].w * v[j].w); }
        const float rstd = rsqrtf(wave_sum(s) * (1.0f / D) + EPS);
#pragma unroll
        for (int j = 0; j < 4; ++j) { const int c = 4 * lane + 256 * j; *(f32x4*)(X + (size_t)row * D + c) = v[j] * rstd * *(const f32x4*)(g + c); }
    }
}
__device__ __forceinline__ void sgu_phase(const Args& a, int idx, LAS unsigned char* lds, int tid, int lane, int wave) {
    constexpr int VPI = 136;
    LAS bf16* VnT = (LAS bf16*)lds;
    LAS float* rs = (LAS float*)(lds + 256 * VPI * 2);
    const bf16* ACT = (const bf16*)(a.ws + OFF_ACT); bf16* Gt = (bf16*)(a.ws + OFF_H);
    const float* SS = (const float*)(a.ws + OFF_SS); const bf16* Ws = (const bf16*)(a.ws + OFF_WSS);
    const float* gn = a.in[15] + idx * 2048; const float* bs = a.in[17] + idx * 8 * 128;
    const int fr = lane & 15, fq = lane >> 4;
    for (int unit = blockIdx.x; unit < 1280; unit += gridDim.x) {
        const int chunk = unit >> 3, g = unit & 7, row0 = chunk * 128;
        if (tid < 128) rs[tid] = rsqrtf(SS[row0 + tid] * (1.0f / 2048.0f) + EPS);
        __syncthreads();
        { const int q = tid >> 2, cb = (tid & 3) * 64; const float rstd = rs[q];
          const bf16* vp = ACT + (size_t)(row0 + q) * 4096 + 2048 + g * 256 + cb; const float* gp = gn + g * 256 + cb;
#pragma unroll 2
          for (int i = 0; i < 8; ++i) { const v4u raw = *(const v4u*)(vp + 8 * i); const f32x4 g0 = *(const f32x4*)(gp + 8 * i), g1 = *(const f32x4*)(gp + 8 * i + 4);
              LAS bf16* dst = VnT + (cb + 8 * i) * VPI + q;
              dst[0 * VPI] = (bf16)f2bf(bflo(raw.x) * rstd * g0.x); dst[1 * VPI] = (bf16)f2bf(bfhi(raw.x) * rstd * g0.y);
              dst[2 * VPI] = (bf16)f2bf(bflo(raw.y) * rstd * g0.z); dst[3 * VPI] = (bf16)f2bf(bfhi(raw.y) * rstd * g0.w);
              dst[4 * VPI] = (bf16)f2bf(bflo(raw.z) * rstd * g1.x); dst[5 * VPI] = (bf16)f2bf(bfhi(raw.z) * rstd * g1.y);
              dst[6 * VPI] = (bf16)f2bf(bflo(raw.w) * rstd * g1.z); dst[7 * VPI] = (bf16)f2bf(bfhi(raw.w) * rstd * g1.w); } }
        __syncthreads();
        f32x4 acc[8][2];
#pragma unroll
        for (int pi = 0; pi < 8; ++pi) { acc[pi][0] = (f32x4){0.f, 0.f, 0.f, 0.f}; acc[pi][1] = (f32x4){0.f, 0.f, 0.f, 0.f}; }
        const bf16* wsg = Ws + (size_t)(idx * 8 + g) * 128 * 128;
#pragma unroll
        for (int ks = 0; ks < 4; ++ks) {
            bf16x8 af[2], bfr[8];
#pragma unroll
            for (int ci = 0; ci < 2; ++ci) af[ci] = *(const LAS bf16x8*)(VnT + (32 * wave + 16 * ci + fr) * VPI + 32 * ks + 8 * fq);
#pragma unroll
            for (int pi = 0; pi < 8; ++pi) bfr[pi] = *(const bf16x8*)(wsg + (16 * pi + fr) * 128 + 32 * ks + 8 * fq);
#pragma unroll
            for (int pi = 0; pi < 8; ++pi)
#pragma unroll
                for (int ci = 0; ci < 2; ++ci) acc[pi][ci] = __builtin_amdgcn_mfma_f32_16x16x32_bf16(af[ci], bfr[pi], acc[pi][ci], 0, 0, 0);
        }
#pragma unroll
        for (int pi = 0; pi < 8; ++pi) { const int p = 16 * pi + fr; const float bias = bs[g * 128 + p];
#pragma unroll
            for (int ci = 0; ci < 2; ++ci) { const int ch = g * 256 + 32 * wave + 16 * ci + 4 * fq;
                const v2u uu = *(const v2u*)(ACT + (size_t)(row0 + p) * 4096 + ch); const f32x4 c = acc[pi][ci];
                v2u o; o.x = pk2((c[0] + bias) * bflo(uu.x), (c[1] + bias) * bfhi(uu.x)); o.y = pk2((c[2] + bias) * bflo(uu.y), (c[3] + bias) * bfhi(uu.y));
                *(v2u*)(Gt + (size_t)(row0 + p) * 2048 + ch) = o; } }
        __syncthreads();
    }
}
template <int HD> __device__ __forceinline__ void pp_phase(const Args& a, int gw, int NGW, int lane, int gt, int GT) {
    constexpr int NQH = 1024 / HD, NH = NQH + 4, LPH = HD / 8, HPP = 64 / LPH, NQKV = 1024 + 4 * HD, QUARTER = HD / 4, XP = LPH / 4;
    constexpr bool NORM = (HD == 128);
    const float qscale = (HD == 128 ? 0.08838834764831845f : 0.125f) * LOG2E;
    const bf16* ACT = (const bf16*)(a.ws + OFF_ACT); bf16* Qb = (bf16*)(a.ws + OFF_H);
    bf16* KL = (bf16*)(a.ws + OFF_KL); bf16* VL = (bf16*)(a.ws + OFF_VL); bf16* KPp = (bf16*)(a.ws + OFF_KP); bf16* VPp = (bf16*)(a.ws + OFF_VP);
    float* outk = a.out + (HD == 128 ? OUT_BK : OUT_CK); float* outv = a.out + (HD == 128 ? OUT_BV : OUT_CV);
    const float* qg = a.in[20]; const float* kg = a.in[21];
    { const float* ck = a.in[HD == 128 ? 2 : 4]; const float* cv = a.in[HD == 128 ? 3 : 5];
      for (int i = gt; i < 4 * 512 * 2 * HD; i += GT) { const int d = i % HD, kh = (i / HD) & 1, j = (i / (2 * HD)) & 511, b = i / (2 * HD * 512);
          KL[((size_t)(b * 2 + kh) * 4608 + j) * HD + d] = (bf16)f2bf(ck[i]); VL[((size_t)(b * 2 + kh) * HD + d) * 4608 + j] = (bf16)f2bf(cv[i]); } }
    const int s = lane % LPH, hl = lane / LPH;
    for (int row = gw; row < M; row += NGW) {
        const bool lat = row >= MP; int b, t;
        if (!lat) { b = row >> 8; t = row & 255; } else { b = (row - MP) >> 12; t = (row - MP) & 4095; }
        float cs[8], sn[8];
        if (lat) { const float pos = (float)(s < LPH / 2 ? (t >> 6) : (t & 63));
#pragma unroll
            for (int e = 0; e < 8; ++e) { const int i = 8 * (s % XP) + e; const float inv = exp2f(-(float)i * (13.287712379549449f / (float)QUARTER)); const float ang = pos * inv; cs[e] = __cosf(ang); sn[e] = __sinf(ang); } }
        else {
#pragma unroll
            for (int e = 0; e < 8; ++e) { cs[e] = 1.f; sn[e] = 0.f; } }
#pragma unroll 1
        for (int pass = 0; pass < 3; ++pass) {
            const int hs = pass * HPP + hl; const bool valid = hs < NH; const int hc = valid ? hs : NH - 1;
            const v4u raw = *(const v4u*)(ACT + (size_t)row * NQKV + hc * HD + 8 * s);
            float x[8] = {bflo(raw.x), bfhi(raw.x), bflo(raw.y), bfhi(raw.y), bflo(raw.z), bfhi(raw.z), bflo(raw.w), bfhi(raw.w)};
            const bool isq = hc < NQH, isk = !isq && hc < NQH + 2, isv = hc >= NQH + 2; const int kh = isk ? hc - NQH : hc - NQH - 2;
            if (NORM) { float ss = 0.f;
#pragma unroll
                for (int e = 0; e < 8; ++e) ss += x[e] * x[e];
#pragma unroll
                for (int o = 1; o < LPH; o <<= 1) ss += __shfl_xor(ss, o);
                const float rstd = rsqrtf(ss * (1.0f / HD) + EPS);
                if (!isv) { const float* gp = (isq ? qg : kg) + 8 * s;
#pragma unroll
                    for (int e = 0; e < 8; ++e) x[e] = x[e] * rstd * gp[e]; } }
            if (isk && !lat && valid) { float* op = outk + ((size_t)(b * 256 + t) * 2 + kh) * HD + 8 * s;
                *(f32x4*)op = (f32x4){x[0], x[1], x[2], x[3]}; *(f32x4*)(op + 4) = (f32x4){x[4], x[5], x[6], x[7]}; }
            if (isv && !lat && valid) { float* op = outv + ((size_t)(b * 256 + t) * 2 + kh) * HD + 8 * s;
                *(f32x4*)op = (f32x4){x[0], x[1], x[2], x[3]}; *(f32x4*)(op + 4) = (f32x4){x[4], x[5], x[6], x[7]}; }
            { float px[8];
#pragma unroll
              for (int e = 0; e < 8; ++e) px[e] = __shfl_xor(x[e], XP);
              if (lat && !isv) { const bool z1 = (s & XP) == 0;
#pragma unroll
                  for (int e = 0; e < 8; ++e) x[e] = z1 ? x[e] * cs[e] - px[e] * sn[e] : x[e] * cs[e] + px[e] * sn[e]; } }
            if (valid) {
                if (isq) { v4u o; o.x = pk2(x[0] * qscale, x[1] * qscale); o.y = pk2(x[2] * qscale, x[3] * qscale); o.z = pk2(x[4] * qscale, x[5] * qscale); o.w = pk2(x[6] * qscale, x[7] * qscale);
                    *(v4u*)(Qb + (size_t)row * 1024 + hc * HD + 8 * s) = o; }
                else if (isk) { v4u o; o.x = pk2(x[0], x[1]); o.y = pk2(x[2], x[3]); o.z = pk2(x[4], x[5]); o.w = pk2(x[6], x[7]);
                    bf16* kp = lat ? KL + ((size_t)(b * 2 + kh) * 4608 + 512 + t) * HD : KPp + ((size_t)(b * 2 + kh) * 256 + t) * HD;
                    *(v4u*)(kp + 8 * s) = o; }
                else { bf16* vp = lat ? VL + ((size_t)(b * 2 + kh) * HD + 8 * s) * 4608 + 512 + t : VPp + ((size_t)(b * 2 + kh) * HD + 8 * s) * 256 + t; const size_t st = lat ? 4608 : 256;
#pragma unroll
                    for (int e = 0; e < 8; ++e) vp[e * st] = (bf16)f2bf(x[e]); }
            }
        }
    }
}
typedef float f32x2_t __attribute__((ext_vector_type(2)));
typedef __bf16 bf16x2_t __attribute__((ext_vector_type(2)));
__device__ __forceinline__ unsigned cvtpk_s(float lo, float hi) { f32x2_t v = {lo, hi}; bf16x2_t b = __builtin_convertvector(v, bf16x2_t); return __builtin_bit_cast(unsigned, b); }
#define MFMA32(a_, b_, c_) __builtin_amdgcn_mfma_f32_32x32x16_bf16((a_), (b_), (c_), 0, 0, 0)
template <int HD, int G, bool SINK>
__device__ __forceinline__ void attn_unit(LAS unsigned char* lds, const bf16* Qb, bf16* Ob, const bf16* Kb, const bf16* Vt, int nkeys, int rowbase, int qcol0,
                                          int n1, int t2lo, int n2, int qpos0, const float* sinkp, int tid, int lane, int wave) {
    constexpr int KS = HD / 16, DB = HD / 32, CPT = HD / 64, KP = HD * 2 + 16, VPB = 144, KBYTES = 64 * KP, VBYTES = HD * VPB, BUF = KBYTES + VBYTES;
    const int g = wave % G, qs = wave / G, r = lane & 31, h = lane >> 5;
    const int qrow = rowbase + qs * 32 + r, hcol = qcol0 + g * HD;
    bf16x8 qf[KS];
#pragma unroll
    for (int ks = 0; ks < KS; ++ks) qf[ks] = *(const bf16x8*)(Qb + (size_t)qrow * 1024 + hcol + 16 * ks + 8 * h);
    f32x16 o[DB];
#pragma unroll
    for (int db = 0; db < DB; ++db)
#pragma unroll
        for (int i = 0; i < 16; ++i) o[db][i] = 0.f;
    float m = -1e30f, l = 0.f;
    if (SINK) { m = sinkp[g] * LOG2E; l = h == 0 ? 1.f : 0.f; }
    const int ntot = n1 + n2;
    int kgo[CPT], klo[CPT], vgo[CPT], vlo[CPT];
#pragma unroll
    for (int i = 0; i < CPT; ++i) { const int c = tid + 512 * i; const int krow = c / (HD / 8), kcc = c % (HD / 8); kgo[i] = krow * HD + kcc * 8; klo[i] = krow * KP + kcc * 16;
        const int vrow = c >> 3, vcc = c & 7; vgo[i] = vrow * nkeys + vcc * 8; vlo[i] = KBYTES + vrow * VPB + vcc * 16; }
    v4u kreg[CPT], vreg[CPT];
#pragma unroll
    for (int i = 0; i < CPT; ++i) { kreg[i] = *(const v4u*)(Kb + kgo[i]); vreg[i] = *(const v4u*)(Vt + vgo[i]); }
#pragma unroll
    for (int i = 0; i < CPT; ++i) { *(LAS v4u*)(lds + klo[i]) = kreg[i]; *(LAS v4u*)(lds + vlo[i]) = vreg[i]; }
    __syncthreads();
    for (int it = 0; it < ntot; ++it) {
        const bool more = it + 1 < ntot;
        if (more) { const int nt = (it + 1) < n1 ? (it + 1) : t2lo + (it + 1 - n1);
#pragma unroll
            for (int i = 0; i < CPT; ++i) { kreg[i] = *(const v4u*)(Kb + (size_t)nt * 64 * HD + kgo[i]); vreg[i] = *(const v4u*)(Vt + nt * 64 + vgo[i]); } }
        LAS unsigned char* cur = lds + (it & 1) * BUF;
        f32x16 s[2];
#pragma unroll
        for (int i = 0; i < 16; ++i) { s[0][i] = 0.f; s[1][i] = 0.f; }
#pragma unroll
        for (int ks = 0; ks < KS; ++ks) {
            const bf16x8 k0 = *(const LAS bf16x8*)(cur + r * KP + (16 * ks + 8 * h) * 2);
            const bf16x8 k1 = *(const LAS bf16x8*)(cur + (32 + r) * KP + (16 * ks + 8 * h) * 2);
            s[0] = MFMA32(k0, qf[ks], s[0]); s[1] = MFMA32(k1, qf[ks], s[1]);
            if ((ks & 1) == 1) asm volatile("" ::: "memory");
        }
        if (n2 > 0 && it >= n1) {
            const int tile = t2lo + it - n1; const int kbase = (tile - 8) * 64 + 4 * h; const int qpos = qpos0 + qs * 32 + r;
#pragma unroll
            for (int i = 0; i < 16; ++i) { const int kp = kbase + (i & 3) + 8 * (i >> 2); const int d0 = qpos - kp, d1 = d0 - 32;
                if (d0 > 128 || d0 < -128) s[0][i] = -1e30f; if (d1 > 128 || d1 < -128) s[1][i] = -1e30f; }
        }
        float mx = fmaxf(s[0][0], s[1][0]);
#pragma unroll
        for (int i = 1; i < 16; ++i) mx = fmaxf(mx, fmaxf(s[0][i], s[1][i]));
        mx = fmaxf(mx, __shfl_xor(mx, 32));
        const float mnew = fmaxf(m, mx); const float alpha = __builtin_amdgcn_exp2f(m - mnew); m = mnew;
        float ps = 0.f;
#pragma unroll
        for (int i = 0; i < 16; ++i) { s[0][i] = __builtin_amdgcn_exp2f(s[0][i] - mnew); s[1][i] = __builtin_amdgcn_exp2f(s[1][i] - mnew); ps += s[0][i] + s[1][i]; }
        l = l * alpha + ps;
#pragma unroll
        for (int db = 0; db < DB; ++db) o[db] = o[db] * alpha;
#pragma unroll
        for (int kb = 0; kb < 2; ++kb)
#pragma unroll
            for (int s2 = 0; s2 < 2; ++s2) {
                v4u pw; pw.x = cvtpk_s(s[kb][8 * s2 + 0], s[kb][8 * s2 + 1]); pw.y = cvtpk_s(s[kb][8 * s2 + 2], s[kb][8 * s2 + 3]);
                pw.z = cvtpk_s(s[kb][8 * s2 + 4], s[kb][8 * s2 + 5]); pw.w = cvtpk_s(s[kb][8 * s2 + 6], s[kb][8 * s2 + 7]);
                const bf16x8 pb = __builtin_bit_cast(bf16x8, pw);
#pragma unroll
                for (int db = 0; db < DB; ++db) { const LAS unsigned char* vp = cur + KBYTES + (32 * db + r) * VPB + (32 * kb + 16 * s2 + 4 * h) * 2;
                    const s16x4 lo = *(const LAS s16x4*)vp, hi = *(const LAS s16x4*)(vp + 16);
                    const bf16x8 vf = __builtin_shufflevector(lo, hi, 0, 1, 2, 3, 4, 5, 6, 7);
                    o[db] = MFMA32(vf, pb, o[db]); }
            }
        if (more) { LAS unsigned char* nb = lds + ((it + 1) & 1) * BUF;
#pragma unroll
            for (int i = 0; i < CPT; ++i) { *(LAS v4u*)(nb + klo[i]) = kreg[i]; *(LAS v4u*)(nb + vlo[i]) = vreg[i]; } }
        __syncthreads();
    }
    l += __shfl_xor(l, 32); const float inv = 1.0f / l;
#pragma unroll
    for (int db = 0; db < DB; ++db)
#pragma unroll
        for (int ig = 0; ig < 4; ++ig) { v2u w; w.x = cvtpk_s(o[db][4 * ig] * inv, o[db][4 * ig + 1] * inv); w.y = cvtpk_s(o[db][4 * ig + 2] * inv, o[db][4 * ig + 3] * inv);
            *(v2u*)(Ob + (size_t)qrow * 1024 + hcol + 32 * db + 8 * ig + 4 * h) = w; }
}
template <int HD> __device__ __forceinline__ void attn_phase(const Args& a, LAS unsigned char* lds, int tid, int lane, int wave) {
    constexpr int G = HD == 128 ? 4 : 8, QR = 256 / G  , NLAT = 4 * 2 * (4096 / QR), NPR = 16 * 2 * (256 / QR);
    const bf16* Qb = (const bf16*)(a.ws + OFF_H); bf16* Ob = (bf16*)(a.ws + OFF_ACT);
    const bf16* KL = (const bf16*)(a.ws + OFF_KL); const bf16* VL = (const bf16*)(a.ws + OFF_VL); const bf16* KPp = (const bf16*)(a.ws + OFF_KP); const bf16* VPp = (const bf16*)(a.ws + OFF_VP);
    for (int u = blockIdx.x; u < NLAT + NPR; u += gridDim.x) {
        if (u < NLAT) { constexpr int NQB = 4096 / QR; const int b = u / (2 * NQB), kvh = (u / NQB) & 1, qb = u % NQB; const int q0 = qb * QR;
            int n1 = 72, t2lo = 0, n2 = 0;
            if (HD == 64) { n1 = 8; int tlo = (q0 - 128) >> 6; if (tlo < 0) tlo = 0; int thi = (q0 + QR - 1 + 128) >> 6; if (thi > 63) thi = 63; t2lo = 8 + tlo; n2 = thi - tlo + 1; }
            attn_unit<HD, G, HD == 64>(lds, Qb, Ob, KL + (size_t)(b * 2 + kvh) * 4608 * HD, VL + (size_t)(b * 2 + kvh) * HD * 4608, 4608, MP + b * 4096 + q0, kvh * G * HD,
                                      n1, t2lo, n2, q0, a.in[24] + kvh * G, tid, lane, wave);
        } else { constexpr int NQB = 256 / QR; const int v = u - NLAT; const int b = v / (2 * NQB), kvh = (v / NQB) & 1, qb = v % NQB;
            attn_unit<HD, G, HD == 64>(lds, Qb, Ob, KPp + (size_t)(b * 2 + kvh) * 256 * HD, VPp + (size_t)(b * 2 + kvh) * HD * 256, 256, b * 256 + qb * QR, kvh * G * HD,
                                      4, 0, 0, 0, a.in[24] + kvh * G, tid, lane, wave);
        }
    }
}
__global__ void __launch_bounds__(NTHR, 2) mega(Args a) {
    extern __shared__ __attribute__((aligned(16))) unsigned char lds_raw[];
    LAS unsigned char* lds = (LAS unsigned char*)lds_raw;
    cg::grid_group grid = cg::this_grid();
#define TIDS() int tid = threadIdx.x; asm volatile("" : "+v"(tid)); const int lane = tid & 63, wave = __builtin_amdgcn_readfirstlane(tid >> 6); \
    const int gw = blockIdx.x * NWAVES + wave, gt = blockIdx.x * NTHR + tid;
    const int G_ = gridDim.x, NGW = G_ * NWAVES, GT = G_ * NTHR;
    { TIDS(); unsigned char* ws = a.ws;
    mod_items(a, lds, tid, lane, wave);
    __syncthreads();
    { LAS float* scr = (LAS float*)(lds + wave * 16384); unsigned* ctr = (unsigned*)(ws + OFF_CTL);
      for (;;) { int it = 0; if (lane == 0) it = (int)atomicAdd(ctr, 1u); it = __builtin_amdgcn_readfirstlane(it); if (it >= NIT) break; conv_item(a, it, scr, lane); } }
    for (int i = gt; i < 2 * 8 * 128 * 128 / 4; i += GT) { const f32x4 v = ((const f32x4*)a.in[16])[i]; v2u o; o.x = pk2(v.x, v.y); o.y = pk2(v.z, v.w); ((v2u*)(ws + OFF_WSS))[i] = o; }
    }
    grid.sync();
#pragma unroll 1
    for (int l = 0; l < 4; ++l) {
        const int kind = l % 3, idx = l / 3, nst = kind == 0 ? 10 : 11;
#pragma unroll 1
        for (int st = 0; st < nst; ++st) {
            TIDS();
            unsigned char* ws = a.ws; asm volatile("" : "+s"(ws));
            const float* modb = (const float*)(ws + OFF_MOD);
            bf16* H = (bf16*)(ws + OFF_H); bf16* ACT = (bf16*)(ws + OFF_ACT); float* SS = (float*)(ws + OFF_SS);
            int op, sub = 0;
            if (st < 4) { op = st == 0 ? 0 : st == 1 ? 1 : st == 2 ? 2 : 0; sub = st == 3 ? 1 : 0; }
            else if (st >= nst - 3) { const int q = st - (nst - 3); op = q; sub = q == 0 ? 2 : 1; }
            else if (kind == 0) { op = st == 4 ? 3 : st == 5 ? 4 : 2; sub = 2; }
            else { op = st == 4 ? 5 : st == 5 ? 6 : st == 6 ? 7 : 2; sub = 2; }
            if (op == 0) {
                for (int i = gt; i < M; i += GT) SS[i] = 0.f;
                if (l == 0 && sub == 0) norm_phase<true>(a, l, sub, gw, NGW, lane); else norm_phase<false>(a, l, sub, gw, NGW, lane);
            } else if (op == 1) {
                pg8::Gemm g{H, (const bf16*)(ws + OFF_WGU + (size_t)(l * 2 + sub) * SZ_WGU), M, 5632, 1024}; pg8::StaticOrder S; S.init(M, 5632, G_, (int)blockIdx.x);
                pg8::EpiSwiGLU E{ACT, FF};
                pg8::gemm_phase<pg8::EpiSwiGLU, pg8::StaticOrder, true, true>(lds, g, S, E, tid);
            } else if (op == 2) {
                const bf16* A; const bf16* Bt; int K; int mk; float sc;
                if (sub < 2) { A = ACT; Bt = (const bf16*)(ws + OFF_WD + (size_t)(l * 2 + sub) * SZ_WD); K = FF; mk = sub == 0 ? 2 : 8; sc = 0.5f; }
                else if (kind == 0) { A = H; Bt = (const bf16*)(ws + OFF_WAOUT + (size_t)idx * SZ_WAOUT); K = 2048; mk = 5; sc = 1.f; }
                else { A = ACT; Bt = (const bf16*)(ws + (kind == 1 ? OFF_WBOUT : OFF_WCOUT)); K = 1024; mk = 5; sc = 1.f; }
                pg8::Gemm g{A, Bt, M, 1024, K}; pg8::StaticOrder S; S.init(M, 1024, G_, (int)blockIdx.x);
                pg8::EpiRes E{a.out, modb + (size_t)l * 5 * 9216, mk, sc};
                pg8::gemm_phase<pg8::EpiRes, pg8::StaticOrder, true, true>(lds, g, S, E, tid);
            } else if (op == 3 || op == 5) {
                const int N = op == 3 ? 4096 : (kind == 1 ? 1536 : 1280);
                const bf16* Bt = (const bf16*)(ws + (op == 3 ? OFF_WAIN + (size_t)idx * SZ_WAIN : (kind == 1 ? OFF_WBQKV : OFF_WCQKV)));
                pg8::Gemm g{H, Bt, M, N, 1024}; pg8::StaticOrder S; S.init(M, N, G_, (int)blockIdx.x);
                pg8::EpiBf16N E{ACT, N, op == 3 ? SS : nullptr, 8};
                pg8::gemm_phase<pg8::EpiBf16N, pg8::StaticOrder, true, true>(lds, g, S, E, tid);
            } else if (op == 4) {
                sgu_phase(a, idx, lds, tid, lane, wave);
            } else if (op == 6) {
                if (kind == 1) pp_phase<128>(a, gw, NGW, lane, gt, GT); else pp_phase<64>(a, gw, NGW, lane, gt, GT);
            } else {
                if (kind == 1) attn_phase<128>(a, lds, tid, lane, wave); else attn_phase<64>(a, lds, tid, lane, wave);
            }
            grid.sync();
        }
    }
    { TIDS(); final_norm(a, gw, NGW, lane); }
}
extern "C" void kernel_launch(void* const* d_in, const int* in_sizes, int n_in, void* d_out, int out_size, void* d_ws, size_t ws_size, hipStream_t stream) {
    static int grid = 0;
    if (grid == 0) {
        if (n_in != 27 || ws_size < WS_END) { fprintf(stderr, "kernel_launch: need 27 inputs and %zu bytes of workspace (got %d, %zu)\n", (size_t)WS_END, n_in, ws_size); grid = -1; return; }
        int dev = 0, cus = 0, per = 0;
        (void)hipGetDevice(&dev); (void)hipDeviceGetAttribute(&cus, hipDeviceAttributeMultiprocessorCount, dev);
        (void)hipFuncSetAttribute((const void*)mega, hipFuncAttributeMaxDynamicSharedMemorySize, LDS_BYTES);
        (void)hipOccupancyMaxActiveBlocksPerMultiprocessor(&per, (const void*)mega, NTHR, LDS_BYTES);
        (void)hipGetLastError();
        grid = cus > 0 ? cus : 256;
        fprintf(stderr, "kernel_launch: cus %d occupancy %d grid %d ws %zu need %zu\n", cus, per, grid, ws_size, (size_t)WS_END);
    }
    if (grid < 0) return;
    (void)hipMemsetAsync((char*)d_ws + OFF_CTL, 0, 4096, stream);
    Args a{};
    for (int i = 0; i < 27; ++i) a.in[i] = (const float*)d_in[i];
    a.out = (float*)d_out; a.ws = (unsigned char*)d_ws;
    void* args[] = {&a};
    hipError_t e = hipLaunchCooperativeKernel((const void*)mega, dim3(grid), dim3(NTHR), args, LDS_BYTES, stream);
    if (e != hipSuccess) fprintf(stderr, "kernel_launch: cooperative launch failed: %s (grid %d)\n", hipGetErrorString(e), grid);
}
```

```cpp
#include <hip/hip_runtime.h>
#include <hip/hip_cooperative_groups.h>
#include <cstdio>
#include <cstdint>
namespace cg = cooperative_groups;
namespace pg8 {
#define PG8_LAS __attribute__((address_space(3)))
typedef unsigned short bf16_t;
typedef short bf16x8 __attribute__((ext_vector_type(8)));
typedef float f32x4 __attribute__((ext_vector_type(4)));
typedef unsigned u32x4 __attribute__((ext_vector_type(4)));
constexpr int BM = 256, BK = 64, HALF = 128, HTB = HALF * BK * 2  , STAGE_BYTES = 8 * HTB, NXCD = 8, WGM = 8;

__host__ __device__ __forceinline__ int lds_byte(int r, int c) { const int st = (r >> 4) * 2 + (c >> 5), rr = r & 15, cc = c & 31, ob = rr * 64 + cc * 2; return st * 1024 + (ob ^ (((ob >> 9) & 1) << 5)); }
__host__ __device__ __forceinline__ void stage_rc(int b, int& R, int& C) { const int st = b / 1024, sb = b % 1024, swz = sb ^ (((sb >> 9) & 1) << 5); R = (st >> 1) * 16 + swz / 64; C = (st & 1) * 32 + (swz % 64) / 2; }
__host__ __device__ __forceinline__ int perm32(int rho) { const int n = rho >> 4, i = rho & 15; return 8 * (i >> 2) + 4 * n + (i & 3); }

struct Unit { int pm, pn; };
struct Gemm { const bf16_t* A; const bf16_t* Bt; int M, N, K; };

struct StaticOrder {
    int nM, nN, nwg, G, c;
    __host__ __device__ void init(int M, int N, int G_, int c_) { nM = M / BM; nN = N / BM; nwg = nM * nN; G = G_; c = c_; }
    __host__ __device__ bool next(int i, Unit& u) const {
        const long L = (long)i * G + c; if (L >= nwg) return false;
        int wgid = (int)L; { const int q = nwg / NXCD, r = nwg % NXCD, xcd = wgid % NXCD, off = wgid / NXCD; wgid = (xcd < r ? xcd * (q + 1) : r * (q + 1) + (xcd - r) * q) + off; }
        const int nig = WGM * nN, gid = wgid / nig, fm = gid * WGM, gsz = (nM - fm) < WGM ? (nM - fm) : WGM;
        u.pm = fm + ((wgid % nig) % gsz); u.pn = (wgid % nig) / gsz; return true;
    }
    __device__ __forceinline__ void a_ready(const Unit&) const {}
    __device__ __forceinline__ void done(const Unit&) const {}
};

__device__ __forceinline__ unsigned cvt_pk_bf16(float lo, float hi) { unsigned r; asm volatile("v_cvt_pk_bf16_f32 %0, %1, %2" : "=v"(r) : "v"(lo), "v"(hi)); return r; }
typedef float f32x2 __attribute__((ext_vector_type(2)));
__device__ __forceinline__ f32x2 gelu_pk(f32x2 v) {
    const f32x2 av = __builtin_elementwise_abs(v), d = av * 0.2316418882f + 1.0f;
    f32x2 t; t.x = __builtin_amdgcn_rcpf(d.x); t.y = __builtin_amdgcn_rcpf(d.y);
    f32x2 q = t * 0.5307027145f + (-0.7265760135f); q = q * t + 0.7107068705f; q = q * t + (-0.142248368f); q = q * t + 0.127414796f; q = q * t;
    const f32x2 s = (v * v) * (-0.72134752044f);
    f32x2 e; e.x = __builtin_amdgcn_exp2f(s.x); e.y = __builtin_amdgcn_exp2f(s.y);
    const f32x2 m = v * (q * e), r = v - m;
    f32x2 o; o.x = v.x < 0.f ? m.x : r.x; o.y = v.y < 0.f ? m.y : r.y; return o;
}

template <int ACT  > struct EpiBf16 {
    static constexpr bool PERM = true, AFTER_DRAIN = false; static_assert(ACT == 0 || ACT == 1, "EpiBf16: ACT is 0 (none) or 1 (gelu_pk)");
    bf16_t* O; int ldc; const float* bias; int split_cols; size_t split_stride; float scale0;
    __device__ __forceinline__ void operator()(const f32x4 (&acc)[2][2][4][2], const Unit& u, int wr, int wc, int fr, int fq) const {
        const int row0 = u.pm * BM + wr * 64 + fr; int colt = u.pn * BM; bf16_t* base = O;
        float sc = 1.f; if (split_cols) { const int t = colt / split_cols; base += (size_t)t * split_stride; colt -= t * split_cols; if (t == 0) sc = scale0; }
        const int col0 = colt + wc * 32 + 8 * fq, bcol0 = u.pn * BM + wc * 32 + 8 * fq;
        f32x4 bv[2][2];
#pragma unroll
        for (int bj = 0; bj < 2; ++bj)
#pragma unroll
            for (int n = 0; n < 2; ++n) bv[bj][n] = bias ? *(const f32x4*)(bias + bcol0 + bj * HALF + 4 * n) : (f32x4){0.f, 0.f, 0.f, 0.f};
#pragma unroll
        for (int ai = 0; ai < 2; ++ai)
#pragma unroll
            for (int m = 0; m < 4; ++m) { bf16_t* rowp = base + (size_t)(row0 + ai * HALF + m * 16) * ldc + col0;
#pragma unroll
                for (int bj = 0; bj < 2; ++bj) { f32x4 v0 = acc[ai][bj][m][0] + bv[bj][0], v1 = acc[ai][bj][m][1] + bv[bj][1];
                    if (ACT == 1) { f32x2 a = gelu_pk((f32x2){v0[0], v0[1]}), b = gelu_pk((f32x2){v0[2], v0[3]}), c = gelu_pk((f32x2){v1[0], v1[1]}), d = gelu_pk((f32x2){v1[2], v1[3]});
                        v0 = (f32x4){a.x, a.y, b.x, b.y}; v1 = (f32x4){c.x, c.y, d.x, d.y}; }
                    v0 = v0 * sc; v1 = v1 * sc; u32x4 w; w.x = cvt_pk_bf16(v0[0], v0[1]); w.y = cvt_pk_bf16(v0[2], v0[3]); w.z = cvt_pk_bf16(v1[0], v1[1]); w.w = cvt_pk_bf16(v1[2], v1[3]);
                    *(u32x4*)(rowp + bj * HALF) = w; } }
    }
};
template <class Epi, class Sched, bool ALIGN_EPI = false, bool SP2 = false>
__device__ __forceinline__ void gemm_phase(PG8_LAS unsigned char* lds, const Gemm g, const Sched& S, const Epi& E, const int tid) {
    const int wid = __builtin_amdgcn_readfirstlane(tid >> 6), lane = tid & 63, wr = wid >> 2, wc = wid & 3, fr = lane & 15, fq = lane >> 4;
    const int K = g.K, nt = K / BK;
    unsigned voffA[2], voffB[2];
#pragma unroll
    for (int i = 0; i < 2; ++i) { int R, C; stage_rc(tid * 16 + i * 8192, R, C); const int Rb = Epi::PERM ? ((R & ~31) + perm32(R & 31)) : R;
        voffA[i] = (unsigned)(R * K + C) * 2u; voffB[i] = (unsigned)(Rb * K + C) * 2u; }
    const size_t kstep = (size_t)(BK * 2);
    const size_t hstep = (size_t)HALF * K * 2;
    const size_t tstep = 2 * hstep;
    const unsigned ldsw = (unsigned)wid * 1024u;
    const int aoff = lds_byte(wr * 64 + fr, fq * 8), boff = lds_byte(wc * 32 + fr, fq * 8);
#define PG8_SA(b, h) (((b) * 2 + (h)) * HTB)
#define PG8_SB(b, h) ((4 + (b) * 2 + (h)) * HTB)
#define PG8_STAGE(bufoff, gbase, voff) do { _Pragma("unroll") for (int _i = 0; _i < 2; ++_i) \
        __builtin_amdgcn_global_load_lds((const unsigned*)((const char*)(gbase) + (voff)[_i]), (PG8_LAS unsigned*)(lds + (bufoff) + ldsw + _i * 8192), 16, 0, 0); } while (0)
#define PG8_LDA(dst, b, h) do { _Pragma("unroll") for (int m = 0; m < 4; ++m) _Pragma("unroll") for (int k = 0; k < 2; ++k) dst[m][k] = *(const PG8_LAS bf16x8*)(lds + PG8_SA(b, h) + aoff + m * 2048 + k * 1024); } while (0)
#define PG8_LDB(dst, b, h) do { _Pragma("unroll") for (int n = 0; n < 2; ++n) _Pragma("unroll") for (int k = 0; k < 2; ++k) dst[n][k] = *(const PG8_LAS bf16x8*)(lds + PG8_SB(b, h) + boff + n * 2048 + k * 1024); } while (0)
#define PG8_MMA(ai, bj, At, Bt) do { __builtin_amdgcn_s_setprio(1); _Pragma("unroll") for (int m = 0; m < 4; ++m) _Pragma("unroll") for (int n = 0; n < 2; ++n) _Pragma("unroll") for (int k = 0; k < 2; ++k) \
        acc[ai][bj][m][n] = __builtin_amdgcn_mfma_f32_16x16x32_bf16(Bt[n][k], At[m][k], acc[ai][bj][m][n], 0, 0, 0); __builtin_amdgcn_s_setprio(0); } while (0)
#define PG8_WAIT_V(n) asm volatile("s_waitcnt vmcnt(" #n ")" ::: "memory")
#define PG8_WAIT_L(n) asm volatile("s_waitcnt lgkmcnt(" #n ")" ::: "memory")
#define PG8_BAR __builtin_amdgcn_s_barrier()
#define PG8_SCHED __builtin_amdgcn_sched_barrier(0)
    Unit cur, nxt; int ui = 0;
    if (!S.next(0, cur)) return;
    f32x4 acc[2][2][4][2];
#pragma unroll
    for (int a = 0; a < 2; ++a)
#pragma unroll
        for (int b = 0; b < 2; ++b)
#pragma unroll
            for (int m = 0; m < 4; ++m)
#pragma unroll
                for (int n = 0; n < 2; ++n) acc[a][b][m][n] = (f32x4){0.f, 0.f, 0.f, 0.f};
    bf16x8 At[4][2], B0[2][2], B1[2][2];
    const char* cA = (const char*)g.A + (size_t)cur.pm * tstep; const char* cB = (const char*)g.Bt + (size_t)cur.pn * tstep;
    S.a_ready(cur);
    if constexpr (SP2) {
        PG8_STAGE(PG8_SB(0, 0), cB, voffB); PG8_STAGE(PG8_SB(0, 1), cB + hstep, voffB); PG8_STAGE(PG8_SA(0, 0), cA, voffA); PG8_STAGE(PG8_SA(0, 1), cA + hstep, voffA);
        if (wr == 1) PG8_BAR;
        PG8_WAIT_V(2); PG8_BAR;
        PG8_STAGE(PG8_SB(1, 0), cB + kstep, voffB); PG8_STAGE(PG8_SA(1, 0), cA + kstep, voffA); PG8_STAGE(PG8_SB(1, 1), cB + hstep + kstep, voffB);
        PG8_WAIT_V(6); PG8_BAR;
    } else {
        PG8_STAGE(PG8_SB(0, 0), cB, voffB); PG8_STAGE(PG8_SA(0, 0), cA, voffA); PG8_STAGE(PG8_SB(0, 1), cB + hstep, voffB); PG8_STAGE(PG8_SA(0, 1), cA + hstep, voffA);
        if (wr == 1) PG8_BAR;
        PG8_WAIT_V(4); PG8_BAR;
        PG8_STAGE(PG8_SB(1, 0), cB + kstep, voffB); PG8_STAGE(PG8_SA(1, 0), cA + kstep, voffA); PG8_STAGE(PG8_SB(1, 1), cB + hstep + kstep, voffB);
        PG8_WAIT_V(6); PG8_BAR;
    }
    for (;;) {
        const bool has_next = S.next(ui + 1, nxt);
        const char* nA = has_next ? (const char*)g.A + (size_t)nxt.pm * tstep : cA; const char* nB = has_next ? (const char*)g.Bt + (size_t)nxt.pn * tstep : cB;
        for (int t = 0; t < nt; t += 2) {
            const bool last = (t == nt - 2);
            const char* a1 = cA + (size_t)(t + 1) * kstep;
            const char* a2 = last ? nA : cA + (size_t)(t + 2) * kstep; const char* b2 = last ? nB : cB + (size_t)(t + 2) * kstep;
            const char* a3 = a2 + kstep; const char* b3 = b2 + kstep;
            if (last && has_next) S.a_ready(nxt);
            if constexpr (SP2) {
            PG8_LDB(B0, 0, 0); PG8_LDB(B1, 0, 1); PG8_SCHED; PG8_LDA(At, 0, 0); PG8_STAGE(PG8_SA(1, 1), a1 + hstep, voffA);
            PG8_WAIT_V(8); PG8_WAIT_L(0); PG8_BAR; PG8_MMA(0, 0, At, B0); PG8_MMA(0, 1, At, B1); PG8_BAR; PG8_SCHED;
            PG8_LDA(At, 0, 1); PG8_STAGE(PG8_SB(0, 0), b2, voffB); PG8_STAGE(PG8_SB(0, 1), b2 + hstep, voffB); PG8_STAGE(PG8_SA(0, 0), a2, voffA);
            PG8_WAIT_V(8); PG8_WAIT_L(0); PG8_BAR; PG8_MMA(1, 0, At, B0); PG8_MMA(1, 1, At, B1); PG8_BAR; PG8_SCHED;
            PG8_LDB(B0, 1, 0); PG8_LDB(B1, 1, 1); PG8_SCHED; PG8_LDA(At, 1, 0); PG8_STAGE(PG8_SA(0, 1), a2 + hstep, voffA);
            PG8_WAIT_V(8); PG8_WAIT_L(0); PG8_BAR; PG8_MMA(0, 0, At, B0); PG8_MMA(0, 1, At, B1); PG8_BAR; PG8_SCHED;
            PG8_LDA(At, 1, 1); PG8_STAGE(PG8_SB(1, 0), b3, voffB); PG8_STAGE(PG8_SB(1, 1), b3 + hstep, voffB); PG8_STAGE(PG8_SA(1, 0), a3, voffA);
            PG8_WAIT_V(8); PG8_WAIT_L(0); PG8_BAR; PG8_MMA(1, 0, At, B0); PG8_MMA(1, 1, At, B1); PG8_BAR; PG8_SCHED;
            } else {
            PG8_LDB(B0, 0, 0); PG8_SCHED; PG8_LDA(At, 0, 0); PG8_STAGE(PG8_SA(1, 1), a1 + hstep, voffA);
            PG8_WAIT_L(8); PG8_BAR; PG8_WAIT_L(0); PG8_MMA(0, 0, At, B0); PG8_BAR; PG8_SCHED;
            PG8_LDB(B1, 0, 1); PG8_STAGE(PG8_SB(0, 0), b2, voffB);
            PG8_BAR; PG8_WAIT_L(0); PG8_MMA(0, 1, At, B1); PG8_BAR;
            PG8_LDA(At, 0, 1); PG8_STAGE(PG8_SA(0, 0), a2, voffA);
            PG8_BAR; PG8_WAIT_L(0); PG8_MMA(1, 0, At, B0); PG8_BAR; PG8_SCHED;
            PG8_STAGE(PG8_SB(0, 1), b2 + hstep, voffB);
            PG8_WAIT_V(6); PG8_BAR; PG8_MMA(1, 1, At, B1); PG8_BAR;
            PG8_LDB(B0, 1, 0); PG8_SCHED; PG8_LDA(At, 1, 0); PG8_STAGE(PG8_SA(0, 1), a2 + hstep, voffA);
            PG8_WAIT_L(8); PG8_BAR; PG8_WAIT_L(0); PG8_MMA(0, 0, At, B0); PG8_BAR; PG8_SCHED;
            PG8_LDB(B1, 1, 1); PG8_STAGE(PG8_SB(1, 0), b3, voffB);
            PG8_BAR; PG8_WAIT_L(0); PG8_MMA(0, 1, At, B1); PG8_BAR;
            PG8_LDA(At, 1, 1); PG8_STAGE(PG8_SA(1, 0), a3, voffA);
            PG8_BAR; PG8_WAIT_L(0); PG8_MMA(1, 0, At, B0); PG8_BAR; PG8_SCHED;
            PG8_STAGE(PG8_SB(1, 1), b3 + hstep, voffB);
            PG8_WAIT_V(6); PG8_BAR; PG8_MMA(1, 1, At, B1); PG8_BAR;
            }
        }
        if constexpr (ALIGN_EPI) { if (wr == 0) PG8_BAR; }
        if constexpr (!Epi::AFTER_DRAIN) { E(acc, cur, wr, wc, fr, fq); S.done(cur); }
        if (!has_next) break;
#pragma unroll
        for (int a = 0; a < 2; ++a)
#pragma unroll
            for (int b = 0; b < 2; ++b)
#pragma unroll
                for (int m = 0; m < 4; ++m)
#pragma unroll
                    for (int n = 0; n < 2; ++n) acc[a][b][m][n] = (f32x4){0.f, 0.f, 0.f, 0.f};
        cur = nxt; cA = nA; cB = nB; ++ui;
        if constexpr (ALIGN_EPI) { if (wr == 1) PG8_BAR; }
    }
    PG8_WAIT_V(0);
    if constexpr (!ALIGN_EPI) { if (wr == 0) PG8_BAR; }
    PG8_BAR;
    if constexpr (Epi::AFTER_DRAIN) { E.fused(acc, cur, wr, wc, fr, fq, lds, wid, lane); S.done(cur); }
#undef PG8_SA
#undef PG8_SB
#undef PG8_STAGE
#undef PG8_LDA
#undef PG8_LDB
#undef PG8_MMA
#undef PG8_WAIT_V
#undef PG8_WAIT_L
#undef PG8_BAR
#undef PG8_SCHED
}
}
namespace pg8 {
struct EpiSwiGLU {
    static constexpr bool PERM = false, AFTER_DRAIN = false;
    bf16_t* O; int ldc;
    __device__ __forceinline__ void operator()(const f32x4 (&acc)[2][2][4][2], const Unit& u, int wr, int wc, int fr, int fq) const {
        const int row0 = u.pm * BM + wr * 64 + fr;
#pragma unroll
        for (int ai = 0; ai < 2; ++ai)
#pragma unroll
            for (int m = 0; m < 4; ++m) {
                bf16_t* rowp = O + (size_t)(row0 + ai * HALF + m * 16) * ldc;
#pragma unroll
                for (int bj = 0; bj < 2; ++bj) {
                    const int f = 16 * (8 * u.pn + 4 * bj + wc) + 4 * fq;
                    const f32x4 g = acc[ai][bj][m][0], up = acc[ai][bj][m][1];
                    float a[4];
#pragma unroll
                    for (int i = 0; i < 4; ++i) a[i] = g[i] * __builtin_amdgcn_rcpf(1.0f + __expf(-g[i])) * up[i];
                    typedef unsigned u32x2 __attribute__((ext_vector_type(2)));
                    u32x2 w; w.x = cvt_pk_bf16(a[0], a[1]); w.y = cvt_pk_bf16(a[2], a[3]);
                    *(u32x2*)(rowp + f) = w;
                }
            }
    }
};
struct EpiRes {
    static constexpr bool PERM = false, AFTER_DRAIN = false;
    float* X; const float* modl; int k; float s;
    __device__ __forceinline__ void operator()(const f32x4 (&acc)[2][2][4][2], const Unit& u, int wr, int wc, int fr, int fq) const {
        const int r = u.pm < 16 ? 0 : 1 + ((u.pm - 16) >> 4);
        const float* cf = modl + (size_t)(r * 9 + k) * 1024;
        const int col0 = u.pn * BM + wc * 32 + 4 * fq;
        f32x4 cv[2][2];
#pragma unroll
        for (int bj = 0; bj < 2; ++bj)
#pragma unroll
            for (int n = 0; n < 2; ++n) cv[bj][n] = *(const f32x4*)(cf + col0 + bj * HALF + n * 16) * s;
        const int row0 = u.pm * BM + wr * 64 + fr;
#pragma unroll
        for (int ai = 0; ai < 2; ++ai)
#pragma unroll
            for (int m = 0; m < 4; ++m) {
                float* rowp = X + (size_t)(row0 + ai * HALF + m * 16) * 1024 + col0;
#pragma unroll
                for (int bj = 0; bj < 2; ++bj)
#pragma unroll
                    for (int n = 0; n < 2; ++n) { f32x4* p = (f32x4*)(rowp + bj * HALF + n * 16); *p = *p + cv[bj][n] * acc[ai][bj][m][n]; }
            }
    }
};
struct EpiBf16N {
    static constexpr bool PERM = false, AFTER_DRAIN = false;
    bf16_t* O; int ldc; float* SS; int sspn;
    __device__ __forceinline__ void operator()(const f32x4 (&acc)[2][2][4][2], const Unit& u, int wr, int wc, int fr, int fq) const {
        typedef unsigned u32x2 __attribute__((ext_vector_type(2)));
        const int row0 = u.pm * BM + wr * 64 + fr; const int col0 = u.pn * BM + wc * 32 + 4 * fq;
        const bool isv = SS != nullptr && u.pn >= sspn;
#pragma unroll
        for (int ai = 0; ai < 2; ++ai)
#pragma unroll
            for (int m = 0; m < 4; ++m) {
                const int row = row0 + ai * HALF + m * 16;
                bf16_t* rowp = O + (size_t)row * ldc + col0; float ss = 0.f;
#pragma unroll
                for (int bj = 0; bj < 2; ++bj)
#pragma unroll
                    for (int n = 0; n < 2; ++n) { const f32x4 v = acc[ai][bj][m][n];
                        ss += (v[0] * v[0] + v[1] * v[1]) + (v[2] * v[2] + v[3] * v[3]);
                        u32x2 w; w.x = cvt_pk_bf16(v[0], v[1]); w.y = cvt_pk_bf16(v[2], v[3]);
                        *(u32x2*)(rowp + bj * HALF + n * 16) = w; }
                if (isv) { ss += __shfl_xor(ss, 16); ss += __shfl_xor(ss, 32); if (fq == 0) atomicAdd(SS + row, ss); }
            }
    }
};
}

#define LAS __attribute__((address_space(3)))
typedef unsigned short bf16;
typedef unsigned v4u __attribute__((ext_vector_type(4)));
typedef unsigned v2u __attribute__((ext_vector_type(2)));
typedef float f32x4 __attribute__((ext_vector_type(4)));
typedef float f32x16 __attribute__((ext_vector_type(16)));
typedef short bf16x8 __attribute__((ext_vector_type(8)));
typedef short s16x4 __attribute__((ext_vector_type(4)));

constexpr int D = 1024, MP = 4096, MS = 16384, M = MP + MS, FF = 2816, NTHR = 512, NWAVES = 8;
constexpr float EPS = 1e-6f;
constexpr float LOG2E = 1.4426950408889634f;
constexpr int LDS_BYTES = 147456;

constexpr size_t MiB = 1u << 20;
constexpr size_t OFF_CTL = 0;
constexpr size_t OFF_MOD = 1 * MiB;
constexpr size_t OFF_SS = 2 * MiB;
constexpr size_t OFF_WSS = 3 * MiB;
constexpr size_t OFF_WGU = 4 * MiB;
constexpr size_t SZ_WGU = (size_t)5632 * 1024 * 2;
constexpr size_t OFF_WD = OFF_WGU + 8 * SZ_WGU;
constexpr size_t SZ_WD = (size_t)1024 * 2816 * 2;
constexpr size_t OFF_WAIN = OFF_WD + 8 * SZ_WD;
constexpr size_t SZ_WAIN = (size_t)4096 * 1024 * 2;
constexpr size_t OFF_WAOUT = OFF_WAIN + 2 * SZ_WAIN;
constexpr size_t SZ_WAOUT = (size_t)1024 * 2048 * 2;
constexpr size_t OFF_WBQKV = OFF_WAOUT + 2 * SZ_WAOUT;
constexpr size_t OFF_WBOUT = OFF_WBQKV + (size_t)1536 * 1024 * 2;
constexpr size_t OFF_WCQKV = OFF_WBOUT + (size_t)1024 * 1024 * 2;
constexpr size_t OFF_WCOUT = OFF_WCQKV + (size_t)1280 * 1024 * 2;
constexpr size_t OFF_H = OFF_WCOUT + (size_t)1024 * 1024 * 2;
constexpr size_t OFF_ACT = OFF_H + (size_t)M * 2048 * 2;
constexpr size_t OFF_KL = OFF_ACT + (size_t)M * 4096 * 2;
constexpr size_t SZ_KL = (size_t)4 * 2 * 4608 * 128 * 2;
constexpr size_t OFF_VL = OFF_KL + SZ_KL;
constexpr size_t OFF_KP = OFF_VL + SZ_KL;
constexpr size_t SZ_KPP = (size_t)16 * 2 * 256 * 128 * 2;
constexpr size_t OFF_VP = OFF_KP + SZ_KPP;
constexpr size_t WS_END = OFF_VP + SZ_KPP;
static_assert(OFF_WGU % 256 == 0 && OFF_H % 256 == 0 && OFF_ACT % 256 == 0 && OFF_KL % 256 == 0, "align");

constexpr size_t OUT_BK = (size_t)M * D, OUT_BV = OUT_BK + 16 * 256 * 2 * 128, OUT_CK = OUT_BV + 16 * 256 * 2 * 128, OUT_CV = OUT_CK + 16 * 256 * 2 * 64;

struct Args { const float* in[27]; float* out; unsigned char* ws; };

__device__ __forceinline__ unsigned f2bf(float f) { unsigned u = __builtin_bit_cast(unsigned, f); return (u + 0x7fffu + ((u >> 16) & 1u)) >> 16; }
__device__ __forceinline__ unsigned pk2(float lo, float hi) { return pg8::cvt_pk_bf16(lo, hi); }
__device__ __forceinline__ float bflo(unsigned w) { return __builtin_bit_cast(float, w << 16); }
__device__ __forceinline__ float bfhi(unsigned w) { return __builtin_bit_cast(float, w & 0xffff0000u); }
__device__ __forceinline__ float wave_sum(float v) {
#pragma unroll
    for (int o = 1; o < 64; o <<= 1) v += __shfl_xor(v, o);
    return v;
}
__device__ __forceinline__ int modrow(int row) { return row < MP ? 0 : 1 + ((row - MP) >> 12); }

__device__ __forceinline__ void transpose_item(const float* W, int K, int N, bf16* WT, int mode, LAS float* scr, int item, int lane) {
    const int nblk = N / 32, kb = item / nblk, nb = item % nblk, k0 = 64 * kb, n0 = 32 * nb;
#pragma unroll 8
    for (int i = 0; i < 32; ++i) { const int kk = 2 * i + (lane >> 5); scr[kk * 33 + (lane & 31)] = W[(size_t)(k0 + kk) * N + n0 + (lane & 31)]; }
    asm volatile("s_waitcnt lgkmcnt(0)" ::: "memory");
    const int c = lane & 7;
#pragma unroll
    for (int j = 0; j < 4; ++j) { const int n = (lane >> 3) + 8 * j; const LAS float* s = scr + (8 * c) * 33 + n;
        v4u o; o.x = pk2(s[0 * 33], s[1 * 33]); o.y = pk2(s[2 * 33], s[3 * 33]); o.z = pk2(s[4 * 33], s[5 * 33]); o.w = pk2(s[6 * 33], s[7 * 33]);
        const int nn = n0 + n; const int np = mode == 0 ? nn : ((nn >> 4) * 32 + (nn & 15) + (mode == 2 ? 16 : 0));
        *(v4u*)(WT + (size_t)np * K + k0 + 8 * c) = o; }
    asm volatile("s_waitcnt lgkmcnt(0)" ::: "memory");
}
constexpr int IT_GU = 16 * 88, IT_D = 44 * 32, IT_AIN = 16 * 128, IT_AOUT = 32 * 32, IT_BQKV = 16 * 48, IT_O = 16 * 32, IT_CQKV = 16 * 40;
constexpr int NIT = 16 * IT_GU + 8 * IT_D + 2 * IT_AIN + 2 * IT_AOUT + IT_BQKV + IT_O + IT_CQKV + IT_O;
__device__ __forceinline__ void conv_item(const Args& a, int it, LAS float* scr, int lane) {
    unsigned char* ws = a.ws; int r = it;
    if (r < 16 * IT_GU) { const int mat = r / IT_GU, ls = mat >> 1, up = mat & 1; r -= mat * IT_GU;
        transpose_item(a.in[up ? 12 : 11] + (size_t)ls * 1024 * FF, 1024, FF, (bf16*)(ws + OFF_WGU + ls * SZ_WGU), 1 + up, scr, r, lane); return; }
    r -= 16 * IT_GU;
    if (r < 8 * IT_D) { const int ls = r / IT_D; r -= ls * IT_D; transpose_item(a.in[13] + (size_t)ls * FF * 1024, FF, 1024, (bf16*)(ws + OFF_WD + ls * SZ_WD), 0, scr, r, lane); return; }
    r -= 8 * IT_D;
    if (r < 2 * IT_AIN) { const int i = r / IT_AIN; r -= i * IT_AIN; transpose_item(a.in[14] + (size_t)i * 1024 * 4096, 1024, 4096, (bf16*)(ws + OFF_WAIN + i * SZ_WAIN), 0, scr, r, lane); return; }
    r -= 2 * IT_AIN;
    if (r < 2 * IT_AOUT) { const int i = r / IT_AOUT; r -= i * IT_AOUT; transpose_item(a.in[18] + (size_t)i * 2048 * 1024, 2048, 1024, (bf16*)(ws + OFF_WAOUT + i * SZ_WAOUT), 0, scr, r, lane); return; }
    r -= 2 * IT_AOUT;
    if (r < IT_BQKV) { transpose_item(a.in[19], 1024, 1536, (bf16*)(ws + OFF_WBQKV), 0, scr, r, lane); return; }
    r -= IT_BQKV;
    if (r < IT_O) { transpose_item(a.in[22], 1024, 1024, (bf16*)(ws + OFF_WBOUT), 0, scr, r, lane); return; }
    r -= IT_O;
    if (r < IT_CQKV) { transpose_item(a.in[23], 1024, 1280, (bf16*)(ws + OFF_WCQKV), 0, scr, r, lane); return; }
    r -= IT_CQKV;
    transpose_item(a.in[25], 1024, 1024, (bf16*)(ws + OFF_WCOUT), 0, scr, r, lane);
}
__device__ __forceinline__ void mod_items(const Args& a, LAS unsigned char* lds, int tid, int lane, int wave) {
    LAS float* sc = (LAS float*)lds;
    LAS float* red = (LAS float*)(lds + 20480);
    float* mod = (float*)(a.ws + OFF_MOD);
    if ((int)blockIdx.x >= 144) return;
    for (int i = tid; i < 5 * 1024; i += NTHR) { const int r = i >> 10, k = i & 1023; const float v = r == 0 ? a.in[7][k] : a.in[6][(r - 1) * 1024 + k]; sc[i] = v / (1.0f + __expf(-v)); }
    __syncthreads();
    for (int item = blockIdx.x; item < 144; item += gridDim.x) {
        const int l = item / 36, cgp = item % 36; const int n0 = cgp * 256 + 4 * lane;
        const float* wp = a.in[8] + ((size_t)l * 1024 + wave * 128) * 9216 + n0;
        f32x4 acc[5];
#pragma unroll
        for (int r = 0; r < 5; ++r) acc[r] = (f32x4){0.f, 0.f, 0.f, 0.f};
#pragma unroll 8
        for (int kk = 0; kk < 128; ++kk) { const f32x4 wv = *(const f32x4*)(wp + (size_t)kk * 9216);
#pragma unroll
            for (int r = 0; r < 5; ++r) acc[r] += wv * sc[r * 1024 + wave * 128 + kk]; }
#pragma unroll
        for (int r = 0; r < 5; ++r) *(LAS f32x4*)(red + (wave * 5 + r) * 256 + 4 * lane) = acc[r];
        __syncthreads();
        for (int idx = tid; idx < 5 * 256; idx += NTHR) { const int r = idx >> 8, c = idx & 255; float s = a.in[9][l * 9216 + cgp * 256 + c];
#pragma unroll
            for (int w = 0; w < 8; ++w) s += red[(w * 5 + r) * 256 + c];
            mod[(size_t)(l * 5 + r) * 9216 + cgp * 256 + c] = s; }
        __syncthreads();
    }
}
template <bool FIRST> __device__ __forceinline__ void norm_phase(const Args& a, int l, int k, int gw, int NGW, int lane) {
    const float* g = a.in[10] + (l * 3 + k) * 1024; const float* mod = (const float*)(a.ws + OFF_MOD) + (size_t)l * 5 * 9216;
    float* X = a.out; bf16* H = (bf16*)(a.ws + OFF_H);
    for (int row = gw; row < M; row += NGW) {
        const float* src = FIRST ? (row < MP ? a.in[0] + (size_t)row * D : a.in[1] + (size_t)(row - MP) * D) : X + (size_t)row * D;
        f32x4 v[4]; float s = 0.f;
#pragma unroll
        for (int j = 0; j < 4; ++j) { v[j] = *(const f32x4*)(src + 4 * lane + 256 * j); s += (v[j].x * v[j].x + v[j].y * v[j].y) + (v[j].z * v[j].z + v[j].w * v[j].w); }
        const float rstd = rsqrtf(wave_sum(s) * (1.0f / D) + EPS);
        const float* sh = mod + (size_t)(modrow(row) * 9 + 3 * k) * 1024; const float* sc = sh + 1024;
#pragma unroll
        for (int j = 0; j < 4; ++j) { const int c = 4 * lane + 256 * j; const f32x4 gg = *(const f32x4*)(g + c), s4 = *(const f32x4*)(sh + c), c4 = *(const f32x4*)(sc + c);
            const f32x4 y = v[j] * rstd * gg * (c4 + 1.0f) + s4; v2u o; o.x = pk2(y.x, y.y); o.y = pk2(y.z, y.w);
            *(v2u*)(H + (size_t)row * 1024 + c) = o;
            if (FIRST) *(f32x4*)(X + (size_t)row * D + c) = v[j]; }
    }
}
__device__ __forceinline__ void final_norm(const Args& a, int gw, int NGW, int lane) {
    const float* g = a.in[26]; float* X = a.out;
    for (int row = gw; row < M; row += NGW) {
        f32x4 v[4]; float s = 0.f;
#pragma unroll
        for (int j = 0; j < 4; ++j) { v[j] = *(const f32x4*)(X + (size_t)row * D + 4 * lane + 256 * j); s += (v[j].x * v[j].x + v[j].y * v[j].y) + (v[j].z * v[j].z + v[j].w * v[j].w); }
        const float rstd = rsqrtf(wave_sum(s) * (1.0f / D) + EPS);
#pragma unroll
        for (int j = 0; j < 4; ++j) { const int c = 4 * lane + 256 * j; *(f32x4*)(X + (size_t)row * D + c) = v[j] * rstd * *(const f32x4*)(g + c); }
    }
}
__device__ __forceinline__ void sgu_phase(const Args& a, int idx, LAS unsigned char* lds, int tid, int lane, int wave) {
    constexpr int VPI = 136;
    LAS bf16* VnT = (LAS bf16*)lds;
    LAS float* rs = (LAS float*)(lds + 256 * VPI * 2);
    const bf16* ACT = (const bf16*)(a.ws + OFF_ACT); bf16* Gt = (bf16*)(a.ws + OFF_H);
    const float* SS = (const float*)(a.ws + OFF_SS); const bf16* Ws = (const bf16*)(a.ws + OFF_WSS);
    const float* gn = a.in[15] + idx * 2048; const float* bs = a.in[17] + idx * 8 * 128;
    const int fr = lane & 15, fq = lane >> 4;
    for (int unit = blockIdx.x; unit < 1280; unit += gridDim.x) {
        const int chunk = unit >> 3, g = unit & 7, row0 = chunk * 128;
        if (tid < 128) rs[tid] = rsqrtf(SS[row0 + tid] * (1.0f / 2048.0f) + EPS);
        __syncthreads();
        { const int q = tid >> 2, cb = (tid & 3) * 64; const float rstd = rs[q];
          const bf16* vp = ACT + (size_t)(row0 + q) * 4096 + 2048 + g * 256 + cb; const float* gp = gn + g * 256 + cb;
#pragma unroll 2
          for (int i = 0; i < 8; ++i) { const v4u raw = *(const v4u*)(vp + 8 * i); const f32x4 g0 = *(const f32x4*)(gp + 8 * i), g1 = *(const f32x4*)(gp + 8 * i + 4);
              LAS bf16* dst = VnT + (cb + 8 * i) * VPI + q;
              dst[0 * VPI] = (bf16)f2bf(bflo(raw.x) * rstd * g0.x); dst[1 * VPI] = (bf16)f2bf(bfhi(raw.x) * rstd * g0.y);
              dst[2 * VPI] = (bf16)f2bf(bflo(raw.y) * rstd * g0.z); dst[3 * VPI] = (bf16)f2bf(bfhi(raw.y) * rstd * g0.w);
              dst[4 * VPI] = (bf16)f2bf(bflo(raw.z) * rstd * g1.x); dst[5 * VPI] = (bf16)f2bf(bfhi(raw.z) * rstd * g1.y);
              dst[6 * VPI] = (bf16)f2bf(bflo(raw.w) * rstd * g1.z); dst[7 * VPI] = (bf16)f2bf(bfhi(raw.w) * rstd * g1.w); } }
        __syncthreads();
        f32x4 acc[8][2];
#pragma unroll
        for (int pi = 0; pi < 8; ++pi) { acc[pi][0] = (f32x4){0.f, 0.f, 0.f, 0.f}; acc[pi][1] = (f32x4){0.f, 0.f, 0.f, 0.f}; }
        const bf16* wsg = Ws + (size_t)(idx * 8 + g) * 128 * 128;
#pragma unroll
        for (int ks = 0; ks < 4; ++ks) {
            bf16x8 af[2], bfr[8];
#pragma unroll
            for (int ci = 0; ci < 2; ++ci) af[ci] = *(const LAS bf16x8*)(VnT + (32 * wave + 16 * ci + fr) * VPI + 32 * ks + 8 * fq);
#pragma unroll
            for (int pi = 0; pi < 8; ++pi) bfr[pi] = *(const bf16x8*)(wsg + (16 * pi + fr) * 128 + 32 * ks + 8 * fq);
#pragma unroll
            for (int pi = 0; pi < 8; ++pi)
#pragma unroll
                for (int ci = 0; ci < 2; ++ci) acc[pi][ci] = __builtin_amdgcn_mfma_f32_16x16x32_bf16(af[ci], bfr[pi], acc[pi][ci], 0, 0, 0);
        }
#pragma unroll
        for (int pi = 0; pi < 8; ++pi) { const int p = 16 * pi + fr; const float bias = bs[g * 128 + p];
#pragma unroll
            for (int ci = 0; ci < 2; ++ci) { const int ch = g * 256 + 32 * wave + 16 * ci + 4 * fq;
                const v2u uu = *(const v2u*)(ACT + (size_t)(row0 + p) * 4096 + ch); const f32x4 c = acc[pi][ci];
                v2u o; o.x = pk2((c[0] + bias) * bflo(uu.x), (c[1] + bias) * bfhi(uu.x)); o.y = pk2((c[2] + bias) * bflo(uu.y), (c[3] + bias) * bfhi(uu.y));
                *(v2u*)(Gt + (size_t)(row0 + p) * 2048 + ch) = o; } }
        __syncthreads();
    }
}
template <int HD> __device__ __forceinline__ void pp_phase(const Args& a, int gw, int NGW, int lane, int gt, int GT) {
    constexpr int NQH = 1024 / HD, NH = NQH + 4, LPH = HD / 8, HPP = 64 / LPH, NQKV = 1024 + 4 * HD, QUARTER = HD / 4, XP = LPH / 4;
    constexpr bool NORM = (HD == 128);
    const float qscale = (HD == 128 ? 0.08838834764831845f : 0.125f) * LOG2E;
    const bf16* ACT = (const bf16*)(a.ws + OFF_ACT); bf16* Qb = (bf16*)(a.ws + OFF_H);
    bf16* KL = (bf16*)(a.ws + OFF_KL); bf16* VL = (bf16*)(a.ws + OFF_VL); bf16* KPp = (bf16*)(a.ws + OFF_KP); bf16* VPp = (bf16*)(a.ws + OFF_VP);
    float* outk = a.out + (HD == 128 ? OUT_BK : OUT_CK); float* outv = a.out + (HD == 128 ? OUT_BV : OUT_CV);
    const float* qg = a.in[20]; const float* kg = a.in[21];
    { const float* ck = a.in[HD == 128 ? 2 : 4]; const float* cv = a.in[HD == 128 ? 3 : 5];
      for (int i = gt; i < 4 * 512 * 2 * HD; i += GT) { const int d = i % HD, kh = (i / HD) & 1, j = (i / (2 * HD)) & 511, b = i / (2 * HD * 512);
          KL[((size_t)(b * 2 + kh) * 4608 + j) * HD + d] = (bf16)f2bf(ck[i]); VL[((size_t)(b * 2 + kh) * HD + d) * 4608 + j] = (bf16)f2bf(cv[i]); } }
    const int s = lane % LPH, hl = lane / LPH;
    for (int row = gw; row < M; row += NGW) {
        const bool lat = row >= MP; int b, t;
        if (!lat) { b = row >> 8; t = row & 255; } else { b = (row - MP) >> 12; t = (row - MP) & 4095; }
        float cs[8], sn[8];
        if (lat) { const float pos = (float)(s < LPH / 2 ? (t >> 6) : (t & 63));
#pragma unroll
            for (int e = 0; e < 8; ++e) { const int i = 8 * (s % XP) + e; const float inv = exp2f(-(float)i * (13.287712379549449f / (float)QUARTER)); const float ang = pos * inv; cs[e] = __cosf(ang); sn[e] = __sinf(ang); } }
        else {
#pragma unroll
            for (int e = 0; e < 8; ++e) { cs[e] = 1.f; sn[e] = 0.f; } }
#pragma unroll 1
        for (int pass = 0; pass < 3; ++pass) {
            const int hs = pass * HPP + hl; const bool valid = hs < NH; const int hc = valid ? hs : NH - 1;
            const v4u raw = *(const v4u*)(ACT + (size_t)row * NQKV + hc * HD + 8 * s);
            float x[8] = {bflo(raw.x), bfhi(raw.x), bflo(raw.y), bfhi(raw.y), bflo(raw.z), bfhi(raw.z), bflo(raw.w), bfhi(raw.w)};
            const bool isq = hc < NQH, isk = !isq && hc < NQH + 2, isv = hc >= NQH + 2; const int kh = isk ? hc - NQH : hc - NQH - 2;
            if (NORM) { float ss = 0.f;
#pragma unroll
                for (int e = 0; e < 8; ++e) ss += x[e] * x[e];
#pragma unroll
                for (int o = 1; o < LPH; o <<= 1) ss += __shfl_xor(ss, o);
                const float rstd = rsqrtf(ss * (1.0f / HD) + EPS);
                if (!isv) { const float* gp = (isq ? qg : kg) + 8 * s;
#pragma unroll
                    for (int e = 0; e < 8; ++e) x[e] = x[e] * rstd * gp[e]; } }
            if (isk && !lat && valid) { float* op = outk + ((size_t)(b * 256 + t) * 2 + kh) * HD + 8 * s;
                *(f32x4*)op = (f32x4){x[0], x[1], x[2], x[3]}; *(f32x4*)(op + 4) = (f32x4){x[4], x[5], x[6], x[7]}; }
            if (isv && !lat && valid) { float* op = outv + ((size_t)(b * 256 + t) * 2 + kh) * HD + 8 * s;
                *(f32x4*)op = (f32x4){x[0], x[1], x[2], x[3]}; *(f32x4*)(op + 4) = (f32x4){x[4], x[5], x[6], x[7]}; }
            { float px[8];
#pragma unroll
              for (int e = 0; e < 8; ++e) px[e] = __shfl_xor(x[e], XP);
              if (lat && !isv) { const bool z1 = (s & XP) == 0;
#pragma unroll
                  for (int e = 0; e < 8; ++e) x[e] = z1 ? x[e] * cs[e] - px[e] * sn[e] : x[e] * cs[e] + px[e] * sn[e]; } }
            if (valid) {
                if (isq) { v4u o; o.x = pk2(x[0] * qscale, x[1] * qscale); o.y = pk2(x[2] * qscale, x[3] * qscale); o.z = pk2(x[4] * qscale, x[5] * qscale); o.w = pk2(x[6] * qscale, x[7] * qscale);
                    *(v4u*)(Qb + (size_t)row * 1024 + hc * HD + 8 * s) = o; }
                else if (isk) { v4u o; o.x = pk2(x[0], x[1]); o.y = pk2(x[2], x[3]); o.z = pk2(x[4], x[5]); o.w = pk2(x[6], x[7]);
                    bf16* kp = lat ? KL + ((size_t)(b * 2 + kh) * 4608 + 512 + t) * HD : KPp + ((size_t)(b * 2 + kh) * 256 + t) * HD;
                    *(v4u*)(kp + 8 * s) = o; }
                else { bf16* vp = lat ? VL + ((size_t)(b * 2 + kh) * HD + 8 * s) * 4608 + 512 + t : VPp + ((size_t)(b * 2 + kh) * HD + 8 * s) * 256 + t; const size_t st = lat ? 4608 : 256;
#pragma unroll
                    for (int e = 0; e < 8; ++e) vp[e * st] = (bf16)f2bf(x[e]); }
            }
        }
    }
}
typedef float f32x2_t __attribute__((ext_vector_type(2)));
typedef __bf16 bf16x2_t __attribute__((ext_vector_type(2)));
__device__ __forceinline__ unsigned cvtpk_s(float lo, float hi) { f32x2_t v = {lo, hi}; bf16x2_t b = __builtin_convertvector(v, bf16x2_t); return __builtin_bit_cast(unsigned, b); }
#define MFMA32(a_, b_, c_) __builtin_amdgcn_mfma_f32_32x32x16_bf16((a_), (b_), (c_), 0, 0, 0)
template <int HD, int G, bool SINK>
__device__ __forceinline__ void attn_unit(LAS unsigned char* lds, const bf16* Qb, bf16* Ob, const bf16* Kb, const bf16* Vt, int nkeys, int rowbase, int qcol0,
                                          int n1, int t2lo, int n2, int qpos0, const float* sinkp, int tid, int lane, int wave) {
    constexpr int KS = HD / 16, DB = HD / 32, CPT = HD / 64, KP = HD * 2 + 16, VPB = 144, KBYTES = 64 * KP, VBYTES = HD * VPB, BUF = KBYTES + VBYTES;
    const int g = wave % G, qs = wave / G, r = lane & 31, h = lane >> 5;
    const int qrow = rowbase + qs * 32 + r, hcol = qcol0 + g * HD;
    bf16x8 qf[KS];
#pragma unroll
    for (int ks = 0; ks < KS; ++ks) qf[ks] = *(const bf16x8*)(Qb + (size_t)qrow * 1024 + hcol + 16 * ks + 8 * h);
    f32x16 o[DB];
#pragma unroll
    for (int db = 0; db < DB; ++db)
#pragma unroll
        for (int i = 0; i < 16; ++i) o[db][i] = 0.f;
    float m = -1e30f, l = 0.f;
    if (SINK) { m = sinkp[g] * LOG2E; l = h == 0 ? 1.f : 0.f; }
    const int ntot = n1 + n2;
    int kgo[CPT], klo[CPT], vgo[CPT], vlo[CPT];
#pragma unroll
    for (int i = 0; i < CPT; ++i) { const int c = tid + 512 * i; const int krow = c / (HD / 8), kcc = c % (HD / 8); kgo[i] = krow * HD + kcc * 8; klo[i] = krow * KP + kcc * 16;
        const int vrow = c >> 3, vcc = c & 7; vgo[i] = vrow * nkeys + vcc * 8; vlo[i] = KBYTES + vrow * VPB + vcc * 16; }
    v4u kreg[CPT], vreg[CPT];
#pragma unroll
    for (int i = 0; i < CPT; ++i) { kreg[i] = *(const v4u*)(Kb + kgo[i]); vreg[i] = *(const v4u*)(Vt + vgo[i]); }
#pragma unroll
    for (int i = 0; i < CPT; ++i) { *(LAS v4u*)(lds + klo[i]) = kreg[i]; *(LAS v4u*)(lds + vlo[i]) = vreg[i]; }
    __syncthreads();
    for (int it = 0; it < ntot; ++it) {
        const bool more = it + 1 < ntot;
        if (more) { const int nt = (it + 1) < n1 ? (it + 1) : t2lo + (it + 1 - n1);
#pragma unroll
            for (int i = 0; i < CPT; ++i) { kreg[i] = *(const v4u*)(Kb + (size_t)nt * 64 * HD + kgo[i]); vreg[i] = *(const v4u*)(Vt + nt * 64 + vgo[i]); } }
        LAS unsigned char* cur = lds + (it & 1) * BUF;
        f32x16 s[2];
#pragma unroll
        for (int i = 0; i < 16; ++i) { s[0][i] = 0.f; s[1][i] = 0.f; }
#pragma unroll
        for (int ks = 0; ks < KS; ++ks) {
            const bf16x8 k0 = *(const LAS bf16x8*)(cur + r * KP + (16 * ks + 8 * h) * 2);
            const bf16x8 k1 = *(const LAS bf16x8*)(cur + (32 + r) * KP + (16 * ks + 8 * h) * 2);
            s[0] = MFMA32(k0, qf[ks], s[0]); s[1] = MFMA32(k1, qf[ks], s[1]);
            if ((ks & 1) == 1) asm volatile("" ::: "memory");
        }
        if (n2 > 0 && it >= n1) {
            const int tile = t2lo + it - n1; const int kbase = (tile - 8) * 64 + 4 * h; const int qpos = qpos0 + qs * 32 + r;
#pragma unroll
            for (int i = 0; i < 16; ++i) { const int kp = kbase + (i & 3) + 8 * (i >> 2); const int d0 = qpos - kp, d1 = d0 - 32;
                if (d0 > 128 || d0 < -128) s[0][i] = -1e30f; if (d1 > 128 || d1 < -128) s[1][i] = -1e30f; }
        }
        float mx = fmaxf(s[0][0], s[1][0]);
#pragma unroll
        for (int i = 1; i < 16; ++i) mx = fmaxf(mx, fmaxf(s[0][i], s[1][i]));
        mx = fmaxf(mx, __shfl_xor(mx, 32));
        const float mnew = fmaxf(m, mx); const float alpha = __builtin_amdgcn_exp2f(m - mnew); m = mnew;
        float ps = 0.f;
#pragma unroll
        for (int i = 0; i < 16; ++i) { s[0][i] = __builtin_amdgcn_exp2f(s[0][i] - mnew); s[1][i] = __builtin_amdgcn_exp2f(s[1][i] - mnew); ps += s[0][i] + s[1][i]; }
        l = l * alpha + ps;
#pragma unroll
        for (int db = 0; db < DB; ++db) o[db] = o[db] * alpha;
#pragma unroll
        for (int kb = 0; kb < 2; ++kb)
#pragma unroll
            for (int s2 = 0; s2 < 2; ++s2) {
                v4u pw; pw.x = cvtpk_s(s[kb][8 * s2 + 0], s[kb][8 * s2 + 1]); pw.y = cvtpk_s(s[kb][8 * s2 + 2], s[kb][8 * s2 + 3]);
                pw.z = cvtpk_s(s[kb][8 * s2 + 4], s[kb][8 * s2 + 5]); pw.w = cvtpk_s(s[kb][8 * s2 + 6], s[kb][8 * s2 + 7]);
                const bf16x8 pb = __builtin_bit_cast(bf16x8, pw);
#pragma unroll
                for (int db = 0; db < DB; ++db) { const LAS unsigned char* vp = cur + KBYTES + (32 * db + r) * VPB + (32 * kb + 16 * s2 + 4 * h) * 2;
                    const s16x4 lo = *(const LAS s16x4*)vp, hi = *(const LAS s16x4*)(vp + 16);
                    const bf16x8 vf = __builtin_shufflevector(lo, hi, 0, 1, 2, 3, 4, 5, 6, 7);
                    o[db] = MFMA32(vf, pb, o[db]); }
            }
        if (more) { LAS unsigned char* nb = lds + ((it + 1) & 1) * BUF;
#pragma unroll
            for (int i = 0; i < CPT; ++i) { *(LAS v4u*)(nb + klo[i]) = kreg[i]; *(LAS v4u*)(nb + vlo[i]) = vreg[i]; } }
        __syncthreads();
    }
    l += __shfl_xor(l, 32); const float inv = 1.0f / l;
#pragma unroll
    for (int db = 0; db < DB; ++db)
#pragma unroll
        for (int ig = 0; ig < 4; ++ig) { v2u w; w.x = cvtpk_s(o[db][4 * ig] * inv, o[db][4 * ig + 1] * inv); w.y = cvtpk_s(o[db][4 * ig + 2] * inv, o[db][4 * ig + 3] * inv);
            *(v2u*)(Ob + (size_t)qrow * 1024 + hcol + 32 * db + 8 * ig + 4 * h) = w; }
}
template <int HD> __device__ __forceinline__ void attn_phase(const Args& a, LAS unsigned char* lds, int tid, int lane, int wave) {
    constexpr int G = HD == 128 ? 4 : 8, QR = 256 / G  , NLAT = 4 * 2 * (4096 / QR), NPR = 16 * 2 * (256 / QR);
    const bf16* Qb = (const bf16*)(a.ws + OFF_H); bf16* Ob = (bf16*)(a.ws + OFF_ACT);
    const bf16* KL = (const bf16*)(a.ws + OFF_KL); const bf16* VL = (const bf16*)(a.ws + OFF_VL); const bf16* KPp = (const bf16*)(a.ws + OFF_KP); const bf16* VPp = (const bf16*)(a.ws + OFF_VP);
    for (int u = blockIdx.x; u < NLAT + NPR; u += gridDim.x) {
        if (u < NLAT) { constexpr int NQB = 4096 / QR; const int b = u / (2 * NQB), kvh = (u / NQB) & 1, qb = u % NQB; const int q0 = qb * QR;
            int n1 = 72, t2lo = 0, n2 = 0;
            if (HD == 64) { n1 = 8; int tlo = (q0 - 128) >> 6; if (tlo < 0) tlo = 0; int thi = (q0 + QR - 1 + 128) >> 6; if (thi > 63) thi = 63; t2lo = 8 + tlo; n2 = thi - tlo + 1; }
            attn_unit<HD, G, HD == 64>(lds, Qb, Ob, KL + (size_t)(b * 2 + kvh) * 4608 * HD, VL + (size_t)(b * 2 + kvh) * HD * 4608, 4608, MP + b * 4096 + q0, kvh * G * HD,
                                      n1, t2lo, n2, q0, a.in[24] + kvh * G, tid, lane, wave);
        } else { constexpr int NQB = 256 / QR; const int v = u - NLAT; const int b = v / (2 * NQB), kvh = (v / NQB) & 1, qb = v % NQB;
            attn_unit<HD, G, HD == 64>(lds, Qb, Ob, KPp + (size_t)(b * 2 + kvh) * 256 * HD, VPp + (size_t)(b * 2 + kvh) * HD * 256, 256, b * 256 + qb * QR, kvh * G * HD,
                                      4, 0, 0, 0, a.in[24] + kvh * G, tid, lane, wave);
        }
    }
}
#define XB_TMO      128
#define XB_XCNT(j)  (256  + 64 * (j))
#define XB_XSUB(j)  (1280 + 64 * (j))
#define XB_XGEN(j)  (2304 + 64 * (j))
#define XB_TOP      3328
#define XB_TOPGEN   3392
#define XCD_BAR_WORDS 3456
#define XB_SPIN_CAP (1u << 18)

__device__ __forceinline__ unsigned xb_ld(unsigned* p)              { return __hip_atomic_load(p, __ATOMIC_RELAXED, __HIP_MEMORY_SCOPE_AGENT); }
__device__ __forceinline__ unsigned xb_add(unsigned* p, unsigned v) { return __hip_atomic_fetch_add(p, v, __ATOMIC_RELAXED, __HIP_MEMORY_SCOPE_AGENT); }
__device__ __forceinline__ unsigned xb_xcc_id() { return (unsigned)__builtin_amdgcn_s_getreg((3 << 11) | 20) & 0xFu; }
#define XB_SPIN(cond, bar) do { unsigned _sp = 0; while (cond) { __builtin_amdgcn_s_sleep(1); \
    if ((++_sp & 255u) == 0u) { if (xb_ld(&(bar)[XB_TMO])) break; if (_sp > XB_SPIN_CAP) { atomicAdd(&(bar)[XB_TMO], 1u); break; } } } } while (0)

struct XcdBarrier {
    unsigned* bar; unsigned x;
    volatile LAS unsigned* st;
};

__device__ __forceinline__ XcdBarrier xcd_barrier_post(unsigned* bar, volatile LAS unsigned* st) {
    XcdBarrier b; b.bar = bar; b.x = xb_xcc_id(); b.st = st;
    if (threadIdx.x == 0) (void)xb_add(&bar[XB_XCNT(b.x)], 1u);
    return b;
}
__device__ __forceinline__ void xcd_barrier_complete(unsigned* bar, unsigned x, unsigned& nloc, unsigned& nx) {
    const unsigned G = gridDim.x * gridDim.y * gridDim.z;
    unsigned sum, cnt, mine, sp = 0u;
    for (;;) {
        sum = 0u; cnt = 0u; mine = 0u;
#pragma unroll
        for (unsigned j = 0; j < 16; ++j) { const unsigned c = xb_ld(&bar[XB_XCNT(j)]); sum += c; cnt += (c > 0u) ? 1u : 0u; mine = (j == x) ? c : mine; }
        if (sum == G) break;
        __builtin_amdgcn_s_sleep(1);
        if ((++sp & 255u) == 0u) { if (xb_ld(&bar[XB_TMO])) break; if (sp > XB_SPIN_CAP) { atomicAdd(&bar[XB_TMO], 1u); break; } }
    }
    nloc = mine > 0u ? mine : 1u; nx = cnt > 0u ? cnt : 1u;
}

__device__ __forceinline__ void xcd_barrier(const XcdBarrier& b) {
    asm volatile("s_waitcnt vmcnt(0)" ::: "memory");
    __syncthreads();
    if (threadIdx.x == 0) {
        unsigned* bar = b.bar;
        __builtin_amdgcn_s_waitcnt(0);
        unsigned nloc = b.st[0], nx = b.st[1];
        if (nloc == 0u) { xcd_barrier_complete(bar, b.x, nloc, nx); b.st[0] = nloc; b.st[1] = nx; }
        const unsigned old = xb_add(&bar[XB_XSUB(b.x)], 1u);
        const unsigned gen = old / nloc;
        if (old + 1u == (gen + 1u) * nloc) {
            __builtin_amdgcn_fence(__ATOMIC_RELEASE, "agent");
            asm volatile("s_waitcnt vmcnt(0)" ::: "memory");
            const unsigned og = xb_add(&bar[XB_TOP], 1u);
            const unsigned tg = og / nx;
            if (og + 1u == (tg + 1u) * nx) xb_add(&bar[XB_TOPGEN], 1u);
            else XB_SPIN(xb_ld(&bar[XB_TOPGEN]) == tg, bar);
            __builtin_amdgcn_fence(__ATOMIC_ACQUIRE, "agent");
            xb_add(&bar[XB_XGEN(b.x)], 1u);
            asm volatile("s_waitcnt vmcnt(0)" ::: "memory");
        } else {
            XB_SPIN(xb_ld(&bar[XB_XGEN(b.x)]) == gen, bar);
            __builtin_amdgcn_fence(__ATOMIC_ACQUIRE, "agent");
            asm volatile("s_waitcnt vmcnt(0)" ::: "memory");
        }
    }
    __syncthreads();
}

constexpr int REP_SYNC = 1, REP_ATT = 1, REP_NORM = 1, REP_SW = 1, REP_PP = 1, REP_SGU = 1;
__global__ void __launch_bounds__(NTHR, 2) mega(Args a) {
    extern __shared__ __attribute__((aligned(16))) unsigned char lds_raw[];
    LAS unsigned char* lds = (LAS unsigned char*)lds_raw;
    cg::grid_group grid = cg::this_grid();
    volatile LAS unsigned* bst = (volatile LAS unsigned*)(lds + 131072 + 64);
    if (threadIdx.x < 2) bst[threadIdx.x] = 0u;
    __syncthreads();
    const XcdBarrier xbar = xcd_barrier_post((unsigned*)(a.ws + OFF_CTL + 4096), bst);
#define TIDS() int tid = threadIdx.x; asm volatile("" : "+v"(tid)); const int lane = tid & 63, wave = __builtin_amdgcn_readfirstlane(tid >> 6); \
    const int gw = blockIdx.x * NWAVES + wave, gt = blockIdx.x * NTHR + tid;
    const int G_ = gridDim.x, NGW = G_ * NWAVES, GT = G_ * NTHR;
    { TIDS(); unsigned char* ws = a.ws;
    mod_items(a, lds, tid, lane, wave);
    __syncthreads();
    { LAS float* scr = (LAS float*)(lds + wave * 16384); unsigned* ctr = (unsigned*)(ws + OFF_CTL);
      for (;;) { int it = 0; if (lane == 0) it = (int)atomicAdd(ctr, 16u); it = __builtin_amdgcn_readfirstlane(it); if (it >= NIT) break;
#pragma unroll 1
          for (int j = 0; j < 16; ++j) if (it + j < NIT) conv_item(a, it + j, scr, lane); } }
    for (int i = gt; i < 2 * 8 * 128 * 128 / 4; i += GT) { const f32x4 v = ((const f32x4*)a.in[16])[i]; v2u o; o.x = pk2(v.x, v.y); o.y = pk2(v.z, v.w); ((v2u*)(ws + OFF_WSS))[i] = o; }
    }
    grid.sync();
#pragma unroll 1
    for (int l = 0; l < 4; ++l) {
        const int kind = l % 3, idx = l / 3, nst = kind == 0 ? 10 : 11;
#pragma unroll 1
        for (int st = 0; st < nst; ++st) {
            TIDS();
            unsigned char* ws = a.ws; asm volatile("" : "+s"(ws));
            const float* modb = (const float*)(ws + OFF_MOD);
            bf16* H = (bf16*)(ws + OFF_H); bf16* ACT = (bf16*)(ws + OFF_ACT); float* SS = (float*)(ws + OFF_SS);
            int op, sub = 0;
            if (st < 4) { op = st == 0 ? 0 : st == 1 ? 1 : st == 2 ? 2 : 0; sub = st == 3 ? 1 : 0; }
            else if (st >= nst - 3) { const int q = st - (nst - 3); op = q; sub = q == 0 ? 2 : 1; }
            else if (kind == 0) { op = st == 4 ? 3 : st == 5 ? 4 : 2; sub = 2; }
            else { op = st == 4 ? 5 : st == 5 ? 6 : st == 6 ? 7 : 2; sub = 2; }
            if (op == 0) {
                for (int i = gt; i < M; i += GT) SS[i] = 0.f;
                if (l == 0 && sub == 0) norm_phase<true>(a, l, sub, gw, NGW, lane); else norm_phase<false>(a, l, sub, gw, NGW, lane);
            } else if (op == 1) {
                pg8::Gemm g{H, (const bf16*)(ws + OFF_WGU + (size_t)(l * 2 + sub) * SZ_WGU), M, 5632, 1024}; pg8::StaticOrder S; S.init(M, 5632, G_, (int)blockIdx.x);
                pg8::EpiSwiGLU E{ACT, FF};
                pg8::gemm_phase<pg8::EpiSwiGLU, pg8::StaticOrder, true, true>(lds, g, S, E, tid);
            } else if (op == 2) {
                const bf16* A; const bf16* Bt; int K; int mk; float sc;
                if (sub < 2) { A = ACT; Bt = (const bf16*)(ws + OFF_WD + (size_t)(l * 2 + sub) * SZ_WD); K = FF; mk = sub == 0 ? 2 : 8; sc = 0.5f; }
                else if (kind == 0) { A = H; Bt = (const bf16*)(ws + OFF_WAOUT + (size_t)idx * SZ_WAOUT); K = 2048; mk = 5; sc = 1.f; }
                else { A = ACT; Bt = (const bf16*)(ws + (kind == 1 ? OFF_WBOUT : OFF_WCOUT)); K = 1024; mk = 5; sc = 1.f; }
                pg8::Gemm g{A, Bt, M, 1024, K}; pg8::StaticOrder S; S.init(M, 1024, G_, (int)blockIdx.x);
                pg8::EpiRes E{a.out, modb + (size_t)l * 5 * 9216, mk, sc};
                pg8::gemm_phase<pg8::EpiRes, pg8::StaticOrder, true, true>(lds, g, S, E, tid);
            } else if (op == 3 || op == 5) {
                const int N = op == 3 ? 4096 : (kind == 1 ? 1536 : 1280);
                const bf16* Bt = (const bf16*)(ws + (op == 3 ? OFF_WAIN + (size_t)idx * SZ_WAIN : (kind == 1 ? OFF_WBQKV : OFF_WCQKV)));
                pg8::Gemm g{H, Bt, M, N, 1024}; pg8::StaticOrder S; S.init(M, N, G_, (int)blockIdx.x);
                pg8::EpiBf16N E{ACT, N, op == 3 ? SS : nullptr, 8};
                pg8::gemm_phase<pg8::EpiBf16N, pg8::StaticOrder, true, true>(lds, g, S, E, tid);
            } else if (op == 4) {
                sgu_phase(a, idx, lds, tid, lane, wave);
            } else if (op == 6) {
                if (kind == 1) pp_phase<128>(a, gw, NGW, lane, gt, GT); else pp_phase<64>(a, gw, NGW, lane, gt, GT);
            } else {
#pragma unroll 1
                for (int rep = 0; rep < REP_ATT; ++rep) { if (kind == 1) attn_phase<128>(a, lds, tid, lane, wave); else attn_phase<64>(a, lds, tid, lane, wave); }
            }
#pragma unroll 1
            for (int rep = 0; rep < REP_SYNC; ++rep) xcd_barrier(xbar);
        }
    }
    { TIDS(); final_norm(a, gw, NGW, lane); }
}
extern "C" void kernel_launch(void* const* d_in, const int* in_sizes, int n_in, void* d_out, int out_size, void* d_ws, size_t ws_size, hipStream_t stream) {
    static int grid = 0;
    if (grid == 0) {
        if (n_in != 27 || ws_size < WS_END) { fprintf(stderr, "kernel_launch: need 27 inputs and %zu bytes of workspace (got %d, %zu)\n", (size_t)WS_END, n_in, ws_size); grid = -1; return; }
        int dev = 0, cus = 0, per = 0;
        (void)hipGetDevice(&dev); (void)hipDeviceGetAttribute(&cus, hipDeviceAttributeMultiprocessorCount, dev);
        (void)hipFuncSetAttribute((const void*)mega, hipFuncAttributeMaxDynamicSharedMemorySize, LDS_BYTES);
        (void)hipOccupancyMaxActiveBlocksPerMultiprocessor(&per, (const void*)mega, NTHR, LDS_BYTES);
        (void)hipGetLastError();
        grid = cus > 0 ? cus : 256;
        fprintf(stderr, "kernel_launch: cus %d occupancy %d grid %d ws %zu need %zu\n", cus, per, grid, ws_size, (size_t)WS_END);
    }
    if (grid < 0) return;
    (void)hipMemsetAsync((char*)d_ws + OFF_CTL, 0, 32768, stream);
    Args a{};
    for (int i = 0; i < 27; ++i) a.in[i] = (const float*)d_in[i];
    a.out = (float*)d_out; a.ws = (unsigned char*)d_ws;
    void* args[] = {&a};
    hipError_t e = hipLaunchCooperativeKernel((const void*)mega, dim3(grid), dim3(NTHR), args, LDS_BYTES, stream);
    if (e != hipSuccess) fprintf(stderr, "kernel_launch: cooperative launch failed: %s (grid %d)\n", hipGetErrorString(e), grid);
}
```
